# Optimizing an MI355X kernel written in HIP

```python
import jax, jax.numpy as jnp
from jax import lax
import numpy as np

D_MODEL = 2048
BATCH = 2
SEQ = 8192
DEPTH = 2
DEC_BATCH = 4
DEC_SEQ = 8192
PAST_LEN = 128

GRID_W = 64
Q_BLOCK = 128
D_FF = 5632
NORM_EPS = 1e-6
ROPE_BASE = 10000.0
A_HEADS = 8
A_KV_HEADS = 2
A_HEAD_DIM = 128
B_HEADS = 8
B_Q_LORA = 512
B_KV_LORA = 256
B_NOPE_DIM = 128
B_ROPE_DIM = 64
B_V_DIM = 128
POOL_WINDOWS = (2, 4, 8, 16)
POOL_GROUP = D_MODEL // 4
IN_SIZES = (A_HEADS * A_HEAD_DIM, A_KV_HEADS * A_HEAD_DIM, A_KV_HEADS * A_HEAD_DIM, B_Q_LORA, B_KV_LORA, B_ROPE_DIM)
IN_COLS = 1024 + 256 + 256 + 512 + 256 + 64
MIX_WIDTH = A_HEADS * A_HEAD_DIM + B_HEADS * B_V_DIM

kernel_name = 'hybrid_gqa_mla_pool_macaron_encoder'


def rms_norm(x, g):
    xf = x.astype(jnp.float32)
    y = xf * lax.rsqrt(jnp.mean(xf * xf, axis=-1, keepdims=True) + NORM_EPS)
    return (y * g.astype(jnp.float32)).astype(x.dtype)


def swiglu(x, w_gate, w_up, w_down):
    return (jax.nn.silu(x @ w_gate) * (x @ w_up)) @ w_down


def axial_rope_angles(seq_len, rot_dim):
    rows = seq_len // GRID_W
    row = jnp.repeat(jnp.arange(rows, dtype=jnp.float32), GRID_W)
    col = jnp.tile(jnp.arange(GRID_W, dtype=jnp.float32), rows)
    half = rot_dim // 2
    freqs = ROPE_BASE ** (-jnp.arange(0, half, 2, dtype=jnp.float32) / half)
    ang = jnp.concatenate([row[:, None] * freqs, col[:, None] * freqs], axis=-1)
    return jnp.cos(ang), jnp.sin(ang)


def apply_rope(x, cos, sin):
    xp = x.astype(jnp.float32).reshape(*x.shape[:-1], x.shape[-1] // 2, 2)
    x0, x1 = xp[..., 0], xp[..., 1]
    c = cos[None, :, None, :]
    s = sin[None, :, None, :]
    out = jnp.stack([x0 * c - x1 * s, x0 * s + x1 * c], axis=-1)
    return out.reshape(x.shape).astype(x.dtype)


def blocked_attention(q, k, v, scale):
    b, s, h, dq = q.shape
    hkv = k.shape[2]
    g = h // hkv
    dv = v.shape[-1]
    nb = s // Q_BLOCK
    qb = q.reshape(b, nb, Q_BLOCK, hkv, g, dq).transpose(1, 0, 2, 3, 4, 5)

    def one_block(qblk):
        sc = jnp.einsum('bqhgd,bkhd->bhgqk', qblk, k, preferred_element_type=jnp.float32) * scale
        p = jax.nn.softmax(sc, axis=-1).astype(v.dtype)
        return jnp.einsum('bhgqk,bkhe->bqhge', p, v)

    o = lax.map(one_block, qb)
    return o.transpose(1, 0, 2, 3, 4, 5).reshape(b, s, h * dv)


def parallel_attention_mixer(h, w_in, a_q_norm_g, a_k_norm_g, b_cq_norm_g, b_w_uq, b_ckv_norm_g, b_w_ukv, w_out, rope_a, rope_b):
    b, s, _ = h.shape
    offs = [int(v) for v in np.cumsum(IN_SIZES)[:-1]]
    qa, ka, va, cq, ckv, kr = jnp.split(h @ w_in, offs, axis=-1)
    cos_a, sin_a = rope_a
    qa = apply_rope(rms_norm(qa.reshape(b, s, A_HEADS, A_HEAD_DIM), a_q_norm_g), cos_a, sin_a)
    ka = apply_rope(rms_norm(ka.reshape(b, s, A_KV_HEADS, A_HEAD_DIM), a_k_norm_g), cos_a, sin_a)
    va = va.reshape(b, s, A_KV_HEADS, A_HEAD_DIM)
    oa = blocked_attention(qa, ka, va, A_HEAD_DIM ** -0.5)
    cos_b, sin_b = rope_b
    qb = (rms_norm(cq, b_cq_norm_g) @ b_w_uq).reshape(b, s, B_HEADS, B_NOPE_DIM + B_ROPE_DIM)
    q_nope, q_rope = qb[..., :B_NOPE_DIM], qb[..., B_NOPE_DIM:]
    q_rope = apply_rope(q_rope, cos_b, sin_b)
    kv = (rms_norm(ckv, b_ckv_norm_g) @ b_w_ukv).reshape(b, s, B_HEADS, B_NOPE_DIM + B_V_DIM)
    k_nope, vb = kv[..., :B_NOPE_DIM], kv[..., B_NOPE_DIM:]
    k_rope = apply_rope(kr[:, :, None, :], cos_b, sin_b)
    q_full = jnp.concatenate([q_nope, q_rope], axis=-1)
    k_full = jnp.concatenate([k_nope, jnp.broadcast_to(k_rope, (b, s, B_HEADS, B_ROPE_DIM))], axis=-1)
    ob = blocked_attention(q_full, k_full, vb, (B_NOPE_DIM + B_ROPE_DIM) ** -0.5)
    return jnp.concatenate([oa, ob], axis=-1) @ w_out


def multiscale_pool_mixer(h, pool_w, pool_scale):
    b, s, _ = h.shape
    t = jnp.arange(s)
    outs = []
    for gi, w in enumerate(POOL_WINDOWS):
        xf = h[..., gi * POOL_GROUP:(gi + 1) * POOL_GROUP].astype(jnp.float32)
        cs = jnp.concatenate([jnp.zeros((b, 1, POOL_GROUP), jnp.float32), jnp.cumsum(xf, axis=1)], axis=1)
        lo = jnp.clip(t - w // 2, 0, s)
        hi = jnp.clip(t + w // 2, 0, s)
        mean = (cs[:, hi] - cs[:, lo]) / (hi - lo).astype(jnp.float32)[None, :, None]
        pooled = (mean - xf).astype(h.dtype)
        outs.append(pooled @ pool_w[gi])
    return jnp.concatenate(outs, axis=-1) * pool_scale


def ffn_half(x, pre_g, w_gate, w_up, w_down, post_g):
    return x + 0.5 * rms_norm(swiglu(rms_norm(x, pre_g), w_gate, w_up, w_down), post_g)


def run_trunk(x, layers):
    s = x.shape[1]
    rope_a = axial_rope_angles(s, A_HEAD_DIM)
    rope_b = axial_rope_angles(s, B_ROPE_DIM)
    for i in range(DEPTH):
        p = layers[i]
        x = ffn_half(x, *p['ffn1'])
        pre_g, *mix_w, post_g = p['mix']
        hn = rms_norm(x, pre_g)
        if i % 2 == 0:
            m = parallel_attention_mixer(hn, *mix_w, rope_a, rope_b)
        else:
            m = multiscale_pool_mixer(hn, *mix_w)
        x = x + rms_norm(m, post_g)
        x = ffn_half(x, *p['ffn2'])
    return x


def setup_inputs(seed: int = 0) -> dict:
    key = jax.random.key(seed)
    ki = iter(jax.random.split(key, 64))

    def dense(shape, fan_in):
        return jax.random.normal(next(ki), shape, jnp.float32) * fan_in ** -0.5

    def gain(n):
        return 1.0 + 0.05 * jax.random.normal(next(ki), (n,), jnp.float32)

    def ffn(prefix):
        return {prefix + '_pre_g': gain(D_MODEL),
                prefix + '_w_gate': dense((D_MODEL, D_FF), D_MODEL),
                prefix + '_w_up': dense((D_MODEL, D_FF), D_MODEL),
                prefix + '_w_down': dense((D_FF, D_MODEL), D_FF),
                prefix + '_post_g': gain(D_MODEL)}

    d = {}
    d['x_prompt'] = jax.random.normal(next(ki), (BATCH, SEQ, D_MODEL), jnp.float32)
    d['x_sample'] = jax.random.normal(next(ki), (DEC_BATCH, DEC_SEQ, D_MODEL), jnp.float32)
    d.update(ffn('l0_ffn1'))
    d['l0_mix_pre_g'] = gain(D_MODEL)
    d['l0_w_in'] = dense((D_MODEL, IN_COLS), D_MODEL)
    d['l0_a_q_norm_g'] = gain(A_HEAD_DIM)
    d['l0_a_k_norm_g'] = gain(A_HEAD_DIM)
    d['l0_b_cq_norm_g'] = gain(B_Q_LORA)
    d['l0_b_w_uq'] = dense((B_Q_LORA, B_HEADS * (B_NOPE_DIM + B_ROPE_DIM)), B_Q_LORA)
    d['l0_b_ckv_norm_g'] = gain(B_KV_LORA)
    d['l0_b_w_ukv'] = dense((B_KV_LORA, B_HEADS * (B_NOPE_DIM + B_V_DIM)), B_KV_LORA)
    d['l0_w_out'] = dense((MIX_WIDTH, D_MODEL), MIX_WIDTH)
    d['l0_mix_post_g'] = gain(D_MODEL)
    d.update(ffn('l0_ffn2'))
    d.update(ffn('l1_ffn1'))
    d['l1_mix_pre_g'] = gain(D_MODEL)
    d['l1_pool_w'] = dense((len(POOL_WINDOWS), POOL_GROUP, POOL_GROUP), POOL_GROUP)
    d['l1_pool_scale'] = 1.0 + 0.1 * jax.random.normal(next(ki), (D_MODEL,), jnp.float32)
    d['l1_mix_post_g'] = gain(D_MODEL)
    d.update(ffn('l1_ffn2'))
    return d


def reference(x_prompt, x_sample,
              l0_ffn1_pre_g, l0_ffn1_w_gate, l0_ffn1_w_up, l0_ffn1_w_down, l0_ffn1_post_g,
              l0_mix_pre_g, l0_w_in, l0_a_q_norm_g, l0_a_k_norm_g, l0_b_cq_norm_g, l0_b_w_uq,
              l0_b_ckv_norm_g, l0_b_w_ukv, l0_w_out, l0_mix_post_g,
              l0_ffn2_pre_g, l0_ffn2_w_gate, l0_ffn2_w_up, l0_ffn2_w_down, l0_ffn2_post_g,
              l1_ffn1_pre_g, l1_ffn1_w_gate, l1_ffn1_w_up, l1_ffn1_w_down, l1_ffn1_post_g,
              l1_mix_pre_g, l1_pool_w, l1_pool_scale, l1_mix_post_g,
              l1_ffn2_pre_g, l1_ffn2_w_gate, l1_ffn2_w_up, l1_ffn2_w_down, l1_ffn2_post_g):
    layers = [
        {'ffn1': (l0_ffn1_pre_g, l0_ffn1_w_gate, l0_ffn1_w_up, l0_ffn1_w_down, l0_ffn1_post_g),
         'mix': (l0_mix_pre_g, l0_w_in, l0_a_q_norm_g, l0_a_k_norm_g, l0_b_cq_norm_g, l0_b_w_uq,
                 l0_b_ckv_norm_g, l0_b_w_ukv, l0_w_out, l0_mix_post_g),
         'ffn2': (l0_ffn2_pre_g, l0_ffn2_w_gate, l0_ffn2_w_up, l0_ffn2_w_down, l0_ffn2_post_g)},
        {'ffn1': (l1_ffn1_pre_g, l1_ffn1_w_gate, l1_ffn1_w_up, l1_ffn1_w_down, l1_ffn1_post_g),
         'mix': (l1_mix_pre_g, l1_pool_w, l1_pool_scale, l1_mix_post_g),
         'ffn2': (l1_ffn2_pre_g, l1_ffn2_w_gate, l1_ffn2_w_up, l1_ffn2_w_down, l1_ffn2_post_g)},
    ]
    y_prompt = run_trunk(x_prompt, layers)
    y_sample = run_trunk(x_sample, layers)
    return (y_prompt, y_sample)
```

```cpp
#include <hip/hip_runtime.h>
#include <hip/hip_cooperative_groups.h>
#include <cstdio>
#include <cstdint>
namespace cg = cooperative_groups;

#define LAS __attribute__((address_space(3)))
typedef unsigned short bf16_t;
typedef short bf16x8 __attribute__((ext_vector_type(8)));
typedef short s16x4 __attribute__((ext_vector_type(4)));
typedef float f32x4 __attribute__((ext_vector_type(4)));
typedef float f32x16 __attribute__((ext_vector_type(16)));
typedef unsigned u32x4 __attribute__((ext_vector_type(4)));
typedef unsigned u32x2 __attribute__((ext_vector_type(2)));

constexpr int T = 49152, DM = 2048, DFF = 5632, SEQ = 8192, NPROMPT = 16384;
constexpr float EPS = 1e-6f;
constexpr size_t MiB = 1u << 20;
constexpr size_t FFN_W_BYTES = 66 * MiB, WGU_BYTES = 44 * MiB;
constexpr size_t WS_W3 = 1 * MiB;
constexpr size_t OUT_MIXW = 198 * MiB;
constexpr size_t OFF_WIN = 0, OFF_WUQ = 10 * MiB, OFF_WUKV = OFF_WUQ + 3 * MiB / 2, OFF_WOUT = OFF_WUKV + 1 * MiB, OFF_WPOOL = OFF_WOUT + 8 * MiB;
constexpr size_t WS_XN = 67 * MiB;
constexpr size_t WS_X16 = 259 * MiB;
constexpr size_t WS_H = 451 * MiB;
constexpr size_t WS_QQ = WS_H, WS_PB = WS_H + 288 * MiB, WS_MIX = WS_H + 288 * MiB, WS_POOL = WS_H;
constexpr size_t WS_END = 979 * MiB;
constexpr int LDQQ = 3072, LDPB = 1024;

__device__ __forceinline__ unsigned cvt_pk_bf16(float lo, float hi) { unsigned r; asm volatile("v_cvt_pk_bf16_f32 %0, %1, %2" : "=v"(r) : "v"(lo), "v"(hi)); return r; }
typedef float f32x2_t __attribute__((ext_vector_type(2))); typedef __bf16 bf16x2_t __attribute__((ext_vector_type(2)));
__device__ __forceinline__ unsigned cvt_pk_s(float lo, float hi) { f32x2_t v = {lo, hi}; bf16x2_t b = __builtin_convertvector(v, bf16x2_t); return __builtin_bit_cast(unsigned, b); }
__device__ __forceinline__ float bflo(unsigned w) { return __uint_as_float(w << 16); }
__device__ __forceinline__ float bfhi(unsigned w) { return __uint_as_float(w & 0xffff0000u); }
__device__ __forceinline__ int opaque_tid() { int t = threadIdx.x; asm volatile("" : "+v"(t)); return t; }
__device__ __forceinline__ float wave_sum(float v) {
#pragma unroll
    for (int o = 1; o < 64; o <<= 1) v += __shfl_xor(v, o);
    return v;
}

namespace pg8 {
constexpr int BM = 256, BK = 64, HALF = 128, HTB = HALF * BK * 2, STAGE_BYTES = 8 * HTB, NXCD = 8;
__host__ __device__ __forceinline__ int lds_byte(int r, int c) { const int st = (r >> 4) * 2 + (c >> 5), rr = r & 15, cc = c & 31, ob = rr * 64 + cc * 2; return st * 1024 + (ob ^ (((ob >> 9) & 1) << 5)); }
__host__ __device__ __forceinline__ void stage_rc(int b, int& R, int& C) { const int st = b / 1024, sb = b % 1024, swz = sb ^ (((sb >> 9) & 1) << 5); R = (st >> 1) * 16 + swz / 64; C = (st & 1) * 32 + (swz % 64) / 2; }
__host__ __device__ __forceinline__ int perm32(int rho) { const int n = rho >> 4, i = rho & 15; return 8 * (i >> 2) + 4 * n + (i & 3); }

struct Unit { int pm, pn; };
struct Gemm { const bf16_t* A; const bf16_t* Bt; int lda, ldb, M, N, K, agrp; };

struct StaticOrder {
    int nM, nN, nwg, G, c, WGM;
    __device__ void init(int M, int N, int G_, int c_, int wgm = 8) { nM = M / BM; nN = N / BM; nwg = nM * nN; G = G_; c = c_; WGM = wgm; }
    __device__ bool next(int i, Unit& u) const {
        const long L = (long)i * G + c; if (L >= nwg) return false;
        int wgid = (int)L; { const int q = nwg / NXCD, r = nwg % NXCD, xcd = wgid % NXCD, off = wgid / NXCD; wgid = (xcd < r ? xcd * (q + 1) : r * (q + 1) + (xcd - r) * q) + off; }
        const int nig = WGM * nN, gid = wgid / nig, fm = gid * WGM, gsz = (nM - fm) < WGM ? (nM - fm) : WGM;
        u.pm = fm + ((wgid % nig) % gsz); u.pn = (wgid % nig) / gsz; return true;
    }
};

struct EpiBf16 {
    static constexpr bool PERM = true;
    bf16_t* O; int ldc; int coloff; int mode; bf16_t* O2; int ldc2;
    __device__ __forceinline__ void operator()(const f32x4 (&acc)[2][2][4][2], const Unit& u, int wr, int wc, int fr, int fq) const {
        const int row0 = u.pm * BM + wr * 64 + fr; int colt = u.pn * BM + coloff; bf16_t* base = O; int ld = ldc;
        if (mode == 1) { if (u.pn < 4) colt = u.pn * 256; else if (u.pn < 6) colt = 2560 + (u.pn - 4) * 256; else { base = O2; ld = ldc2; colt = (u.pn - 6) * 256; } }
        const int col0 = colt + wc * 32 + 8 * fq;
#pragma unroll
        for (int ai = 0; ai < 2; ++ai)
#pragma unroll
            for (int m = 0; m < 4; ++m) { bf16_t* rowp = base + (size_t)(row0 + ai * HALF + m * 16) * ld + col0;
#pragma unroll
                for (int bj = 0; bj < 2; ++bj) { const f32x4 v0 = acc[ai][bj][m][0], v1 = acc[ai][bj][m][1];
                    u32x4 w; w.x = cvt_pk_s(v0[0], v0[1]); w.y = cvt_pk_s(v0[2], v0[3]); w.z = cvt_pk_s(v1[0], v1[1]); w.w = cvt_pk_s(v1[2], v1[3]);
                    *(u32x4*)(rowp + bj * HALF) = w; } }
    }
};
__device__ __forceinline__ float silu_mul(float g, float u) { return g * __builtin_amdgcn_rcpf(1.0f + __builtin_amdgcn_exp2f(-1.4426950408889634f * g)) * u; }
struct EpiSwiGLU {
    static constexpr bool PERM = true;
    bf16_t* O; int ldc;
    __device__ __forceinline__ void operator()(const f32x4 (&acc)[2][2][4][2], const Unit& u, int wr, int wc, int fr, int fq) const {
        const int row0 = u.pm * BM + wr * 64 + fr; const int col0 = u.pn * HALF + wc * 32 + 8 * fq;
#pragma unroll
        for (int ai = 0; ai < 2; ++ai)
#pragma unroll
            for (int m = 0; m < 4; ++m) { bf16_t* rowp = O + (size_t)(row0 + ai * HALF + m * 16) * ldc + col0;
                const f32x4 g0 = acc[ai][0][m][0], g1 = acc[ai][0][m][1], u0 = acc[ai][1][m][0], u1 = acc[ai][1][m][1];
                const f32x4 a0 = g0 * -1.4426950408889634f, a1 = g1 * -1.4426950408889634f;
                f32x4 e0, e1;
                e0[0] = __builtin_amdgcn_exp2f(a0[0]); e0[1] = __builtin_amdgcn_exp2f(a0[1]); e0[2] = __builtin_amdgcn_exp2f(a0[2]); e0[3] = __builtin_amdgcn_exp2f(a0[3]);
                e1[0] = __builtin_amdgcn_exp2f(a1[0]); e1[1] = __builtin_amdgcn_exp2f(a1[1]); e1[2] = __builtin_amdgcn_exp2f(a1[2]); e1[3] = __builtin_amdgcn_exp2f(a1[3]);
                const f32x4 d0 = e0 + 1.0f, d1 = e1 + 1.0f; const f32x4 t0 = g0 * u0, t1 = g1 * u1;
                f32x4 r0, r1;
                r0[0] = __builtin_amdgcn_rcpf(d0[0]); r0[1] = __builtin_amdgcn_rcpf(d0[1]); r0[2] = __builtin_amdgcn_rcpf(d0[2]); r0[3] = __builtin_amdgcn_rcpf(d0[3]);
                r1[0] = __builtin_amdgcn_rcpf(d1[0]); r1[1] = __builtin_amdgcn_rcpf(d1[1]); r1[2] = __builtin_amdgcn_rcpf(d1[2]); r1[3] = __builtin_amdgcn_rcpf(d1[3]);
                const f32x4 h0 = t0 * r0, h1 = t1 * r1;
                u32x4 w; w.x = cvt_pk_s(h0[0], h0[1]); w.y = cvt_pk_s(h0[2], h0[3]); w.z = cvt_pk_s(h1[0], h1[1]); w.w = cvt_pk_s(h1[2], h1[3]);
                *(u32x4*)rowp = w; }
    }
};

template <class Epi>
__device__ __forceinline__ void gemm_phase(LAS unsigned char* lds, const Gemm g, const StaticOrder& S, const Epi& E) {
    const int tid = opaque_tid(), wid = __builtin_amdgcn_readfirstlane(tid >> 6), lane = tid & 63, wr = wid >> 2, wc = wid & 3, fr = lane & 15, fq = lane >> 4;
    const int K = g.K, nt = K / BK;
    unsigned voffA[2], voffB[2];
#pragma unroll
    for (int i = 0; i < 2; ++i) { int R, C; stage_rc(tid * 16 + i * 8192, R, C); const int Rb = Epi::PERM ? ((R & ~31) + perm32(R & 31)) : R;
        voffA[i] = (unsigned)(R * g.lda + C) * 2u; voffB[i] = (unsigned)(Rb * g.ldb + C) * 2u; }
    const size_t kstep = (size_t)(BK * 2);
    const size_t hstepA = (size_t)HALF * g.lda * 2, hstepB = (size_t)HALF * g.ldb * 2;
    const size_t tstepA = 2 * hstepA, tstepB = 2 * hstepB;
    const unsigned ldsw = (unsigned)wid * 1024u;
    const int aoff = lds_byte(wr * 64 + fr, fq * 8), boff = lds_byte(wc * 32 + fr, fq * 8);
#define PG8_SA(b, h) (((b) * 2 + (h)) * HTB)
#define PG8_SB(b, h) ((4 + (b) * 2 + (h)) * HTB)
#define PG8_STAGE(bufoff, gbase, voff) do { _Pragma("unroll") for (int _i = 0; _i < 2; ++_i) \
        __builtin_amdgcn_global_load_lds((const unsigned*)((const char*)(gbase) + (voff)[_i]), (LAS unsigned*)(lds + (bufoff) + ldsw + _i * 8192), 16, 0, 0); } while (0)
#define PG8_LDA(dst, b, h) do { _Pragma("unroll") for (int m = 0; m < 4; ++m) _Pragma("unroll") for (int k = 0; k < 2; ++k) dst[m][k] = *(const LAS bf16x8*)(lds + PG8_SA(b, h) + aoff + m * 2048 + k * 1024); } while (0)
#define PG8_LDB(dst, b, h) do { _Pragma("unroll") for (int n = 0; n < 2; ++n) _Pragma("unroll") for (int k = 0; k < 2; ++k) dst[n][k] = *(const LAS bf16x8*)(lds + PG8_SB(b, h) + boff + n * 2048 + k * 1024); } while (0)
#define PG8_MMA(ai, bj, At, Bt) do { __builtin_amdgcn_s_setprio(1); _Pragma("unroll") for (int m = 0; m < 4; ++m) _Pragma("unroll") for (int n = 0; n < 2; ++n) _Pragma("unroll") for (int k = 0; k < 2; ++k) \
        acc[ai][bj][m][n] = __builtin_amdgcn_mfma_f32_16x16x32_bf16(Bt[n][k], At[m][k], acc[ai][bj][m][n], 0, 0, 0); __builtin_amdgcn_s_setprio(0); } while (0)
#define PG8_WAIT_V(n) asm volatile("s_waitcnt vmcnt(" #n ")" ::: "memory")
#define PG8_WAIT_L(n) asm volatile("s_waitcnt lgkmcnt(" #n ")" ::: "memory")
#define PG8_BAR __builtin_amdgcn_s_barrier()
#define PG8_SCHED __builtin_amdgcn_sched_barrier(0)
#define PG8_AOFF(u) ((size_t)(u).pm * tstepA + (g.agrp ? (size_t)((u).pn / g.agrp) * (size_t)K * 2 : (size_t)0))
    Unit cur, nxt; int ui = 0;
    if (!S.next(0, cur)) return;
    f32x4 acc[2][2][4][2];
#pragma unroll
    for (int a = 0; a < 2; ++a)
#pragma unroll
        for (int b = 0; b < 2; ++b)
#pragma unroll
            for (int m = 0; m < 4; ++m)
#pragma unroll
                for (int n = 0; n < 2; ++n) acc[a][b][m][n] = (f32x4){0.f, 0.f, 0.f, 0.f};
    bf16x8 At[4][2], B0[2][2], B1[2][2];
    const char* cA = (const char*)g.A + PG8_AOFF(cur); const char* cB = (const char*)g.Bt + (size_t)cur.pn * tstepB;
    PG8_STAGE(PG8_SB(0, 0), cB, voffB); PG8_STAGE(PG8_SB(0, 1), cB + hstepB, voffB); PG8_STAGE(PG8_SA(0, 0), cA, voffA); PG8_STAGE(PG8_SA(0, 1), cA + hstepA, voffA);
    if (wr == 1) PG8_BAR;
    PG8_WAIT_V(2); PG8_BAR;
    PG8_STAGE(PG8_SB(1, 0), cB + kstep, voffB); PG8_STAGE(PG8_SA(1, 0), cA + kstep, voffA); PG8_STAGE(PG8_SB(1, 1), cB + hstepB + kstep, voffB);
    PG8_WAIT_V(6); PG8_BAR;
    for (;;) {
        const bool has_next = S.next(ui + 1, nxt);
        const char* nA = has_next ? (const char*)g.A + PG8_AOFF(nxt) : cA; const char* nB = has_next ? (const char*)g.Bt + (size_t)nxt.pn * tstepB : cB;
        for (int t = 0; t < nt; t += 2) {
            const bool last = (t == nt - 2);
            const char* a1 = cA + (size_t)(t + 1) * kstep;
            const char* a2 = last ? nA : cA + (size_t)(t + 2) * kstep; const char* b2 = last ? nB : cB + (size_t)(t + 2) * kstep;
            const char* a3 = a2 + kstep; const char* b3 = b2 + kstep;
            PG8_LDB(B0, 0, 0); PG8_LDB(B1, 0, 1); PG8_SCHED; PG8_LDA(At, 0, 0); PG8_STAGE(PG8_SA(1, 1), a1 + hstepA, voffA);
            PG8_WAIT_V(8); PG8_WAIT_L(0); PG8_BAR; PG8_MMA(0, 0, At, B0); PG8_MMA(0, 1, At, B1); PG8_BAR; PG8_SCHED;
            PG8_LDA(At, 0, 1); PG8_STAGE(PG8_SB(0, 0), b2, voffB); PG8_STAGE(PG8_SB(0, 1), b2 + hstepB, voffB); PG8_STAGE(PG8_SA(0, 0), a2, voffA);
            PG8_WAIT_V(8); PG8_WAIT_L(0); PG8_BAR; PG8_MMA(1, 0, At, B0); PG8_MMA(1, 1, At, B1); PG8_BAR; PG8_SCHED;
            PG8_LDB(B0, 1, 0); PG8_LDB(B1, 1, 1); PG8_SCHED; PG8_LDA(At, 1, 0); PG8_STAGE(PG8_SA(0, 1), a2 + hstepA, voffA);
            PG8_WAIT_V(8); PG8_WAIT_L(0); PG8_BAR; PG8_MMA(0, 0, At, B0); PG8_MMA(0, 1, At, B1); PG8_BAR; PG8_SCHED;
            PG8_LDA(At, 1, 1); PG8_STAGE(PG8_SB(1, 0), b3, voffB); PG8_STAGE(PG8_SB(1, 1), b3 + hstepB, voffB); PG8_STAGE(PG8_SA(1, 0), a3, voffA);
            PG8_WAIT_V(8); PG8_WAIT_L(0); PG8_BAR; PG8_MMA(1, 0, At, B0); PG8_MMA(1, 1, At, B1); PG8_BAR; PG8_SCHED;
        }
        if (wr == 0) PG8_BAR;
        E(acc, cur, wr, wc, fr, fq);
        if (!has_next) break;
#pragma unroll
        for (int a = 0; a < 2; ++a)
#pragma unroll
            for (int b = 0; b < 2; ++b)
#pragma unroll
                for (int m = 0; m < 4; ++m)
#pragma unroll
                    for (int n = 0; n < 2; ++n) acc[a][b][m][n] = (f32x4){0.f, 0.f, 0.f, 0.f};
        cur = nxt; cA = nA; cB = nB; ++ui;
        if (wr == 1) PG8_BAR;
    }
    PG8_WAIT_V(0);
    PG8_BAR;
#undef PG8_SA
#undef PG8_SB
#undef PG8_STAGE
#undef PG8_LDA
#undef PG8_LDB
#undef PG8_MMA
#undef PG8_WAIT_V
#undef PG8_WAIT_L
#undef PG8_BAR
#undef PG8_SCHED
#undef PG8_AOFF
}
}

namespace att {
constexpr int NW = 8, QBLK = 32, KVBLK = 64;
constexpr int SHM_V = 16384, SHM_K = 16384, SHM_KR = 8192;
constexpr int NSLOT = 3;
constexpr int OFF_V = 0, OFF_K = NSLOT * SHM_V, OFF_KR = OFF_K + NSLOT * SHM_K, OFF_WS = OFF_KR + NSLOT * SHM_KR, OFF_QR = OFF_WS + NW * 64 * 4, LDS_BYTES = OFF_QR + NW * 4096;
constexpr float THR = 8.f;
#define KSWZ(row, colB) ((row) * 256 + ((colB) ^ (((row) & 7) << 4)))
#define KRSWZ(row, chunk) ((row) * 128 + ((((chunk) ^ (((row) >> 1) & 7))) << 4))
#define SBAR() __builtin_amdgcn_sched_barrier(0)
__device__ __forceinline__ int crow(int r, int hi) { return (r & 3) + 8 * (r >> 2) + 4 * hi; }

constexpr float THR2 = 8.f * 1.4426950408889634f;
__device__ __forceinline__ float max3f(float a, float b, float c) { return __builtin_fmaxf(__builtin_fmaxf(a, b), c); }
template <bool FIRST, bool MLA>
__device__ __forceinline__ void partialSM(f32x16& p0, f32x16& p1, f32x16& negm, float& m_reg, float& alpha) {
  float a = max3f(p0[0], p0[1], p1[0]), b = max3f(p0[2], p0[3], p1[1]); a = max3f(a, p1[2], p1[3]);
#pragma unroll
  for (int r = 4; r < 16; r += 4) { a = max3f(a, p0[r], p0[r + 1]); b = max3f(b, p0[r + 2], p0[r + 3]); a = max3f(a, p1[r], p1[r + 1]); b = max3f(b, p1[r + 2], p1[r + 3]); }
  float pmax = fmaxf(a, b);
  { auto rr = __builtin_amdgcn_permlane32_swap(__float_as_uint(pmax), __float_as_uint(pmax), false, false);
    pmax = fmaxf(__uint_as_float(rr[0]), __uint_as_float(rr[1])); }
  alpha = 1.f;
  if constexpr (MLA) {
    if (FIRST) m_reg = pmax;
    else if (!__builtin_expect(__all(pmax - m_reg <= THR2), 1)) { const float mn = fmaxf(m_reg, pmax); alpha = __builtin_amdgcn_exp2f(m_reg - mn); m_reg = mn; }
#pragma unroll
    for (int r = 0; r < 16; ++r) { p0[r] -= m_reg; p1[r] -= m_reg; }
  } else
  if (FIRST || __builtin_expect(__any(pmax > THR2), 0)) {
    const float d = FIRST ? pmax : fmaxf(pmax, 0.f);
#pragma unroll
    for (int r = 0; r < 16; ++r) { p0[r] -= d; p1[r] -= d; }
#pragma unroll
    for (int r = 0; r < 16; ++r) negm[r] -= d;
    asm volatile("" : "+v"(negm));
    if (!FIRST) alpha = __builtin_amdgcn_exp2f(-d);
  }
#pragma unroll
  for (int r = 0; r < 16; ++r) p0[r] = __builtin_amdgcn_exp2f(p0[r]);
}
__device__ __forceinline__ void finishSM(f32x16& p0, f32x16& p1, float alpha, float& l_reg, bf16x8& pa0, bf16x8& pa1, bf16x8& pa2, bf16x8& pa3) {
#pragma unroll
  for (int r = 0; r < 16; ++r) p1[r] = __builtin_amdgcn_exp2f(p1[r]);
  float ps = 0;
#pragma unroll
  for (int r = 0; r < 16; ++r) ps += p0[r];
#pragma unroll
  for (int r = 0; r < 16; ++r) ps += p1[r];
  { auto rr = __builtin_amdgcn_permlane32_swap(__float_as_uint(ps), __float_as_uint(ps), false, false);
    ps = __uint_as_float(rr[0]) + __uint_as_float(rr[1]); }
  l_reg = l_reg * alpha + ps;
#define PK4(P, BASE, OUT) do { unsigned a0 = cvt_pk_bf16(P[BASE + 0], P[BASE + 1]), a1 = cvt_pk_bf16(P[BASE + 2], P[BASE + 3]);   \
    unsigned b0 = cvt_pk_bf16(P[BASE + 4], P[BASE + 5]), b1 = cvt_pk_bf16(P[BASE + 6], P[BASE + 7]);                              \
    auto r0 = __builtin_amdgcn_permlane32_swap(a0, b0, false, false); auto r1 = __builtin_amdgcn_permlane32_swap(a1, b1, false, false); \
    u32x4 w = {r0[0], r1[0], r0[1], r1[1]}; OUT = *reinterpret_cast<bf16x8*>(&w); } while (0)
  PK4(p0, 0, pa0); PK4(p0, 8, pa1); PK4(p1, 0, pa2); PK4(p1, 8, pa3);
#undef PK4
}
template <bool MLA>
__device__ __forceinline__ void qkt(f32x16& p0, f32x16& p1, const char* Ks, const char* KRs, const bf16x8* qr, const char* qrl, const f32x16& negm, int r32, int hi) {
#pragma unroll
  for (int d0 = 0; d0 < 8; ++d0) { int cb = (d0 * 16 + hi * 8) * 2;
    bf16x8 b0 = *reinterpret_cast<const bf16x8*>(Ks + KSWZ(r32, cb));
    bf16x8 b1 = *reinterpret_cast<const bf16x8*>(Ks + KSWZ(32 + r32, cb));
    if (d0 == 0) { p0 = __builtin_amdgcn_mfma_f32_32x32x16_bf16(b0, qr[0], negm, 0, 0, 0); p1 = __builtin_amdgcn_mfma_f32_32x32x16_bf16(b1, qr[0], negm, 0, 0, 0); }
    else { p0 = __builtin_amdgcn_mfma_f32_32x32x16_bf16(b0, qr[d0], p0, 0, 0, 0); p1 = __builtin_amdgcn_mfma_f32_32x32x16_bf16(b1, qr[d0], p1, 0, 0, 0); } }
  if constexpr (MLA) {
#pragma unroll
    for (int d0 = 0; d0 < 4; ++d0) { int ch = d0 * 2 + hi;
      bf16x8 b0 = *reinterpret_cast<const bf16x8*>(KRs + KRSWZ(r32, ch));
      bf16x8 b1 = *reinterpret_cast<const bf16x8*>(KRs + KRSWZ(32 + r32, ch));
      const bf16x8 qq = *reinterpret_cast<const bf16x8*>(qrl + d0 * 1024);
      p0 = __builtin_amdgcn_mfma_f32_32x32x16_bf16(b0, qq, p0, 0, 0, 0);
      p1 = __builtin_amdgcn_mfma_f32_32x32x16_bf16(b1, qq, p1, 0, 0, 0); }
  }
}
__device__ __forceinline__ int v_st(int k, int c) { const int kk = (k & ~0xC) | ((k & 4) << 1) | ((k & 8) >> 1); return ((kk >> 3) * 4 + (c >> 5)) * 512 + ((kk & 7) * 32 + (c & 31)) * 2; }
__device__ __forceinline__ int v_rd_base(int lane) { return ((lane & 3) << 3) | (((lane >> 2) & 3) << 6) | (((lane >> 4) & 1) << 5) | (((lane >> 5) & 1) << 8); }
constexpr int v_rd_off(int d0, int ks, int half) { return d0 * 512 + ks * 4096 + half * 2048; }
template <int OFF> __device__ __forceinline__ s16x4 tr_read(int vb) {
  s16x4 r; asm volatile("ds_read_b64_tr_b16 %0, %1 offset:%2" : "=&v"(r) : "v"(vb), "i"(OFF) : "memory"); return r;
}
template <int D0> __device__ __forceinline__ void pv_one(f32x16& od, int vb, bf16x8 pa0, bf16x8 pa1, bf16x8 pa2, bf16x8 pa3) {
  const s16x4 l0 = tr_read<v_rd_off(D0, 0, 0)>(vb), h0 = tr_read<v_rd_off(D0, 0, 1)>(vb), l1 = tr_read<v_rd_off(D0, 1, 0)>(vb), h1 = tr_read<v_rd_off(D0, 1, 1)>(vb);
  const s16x4 l2 = tr_read<v_rd_off(D0, 2, 0)>(vb), h2 = tr_read<v_rd_off(D0, 2, 1)>(vb), l3 = tr_read<v_rd_off(D0, 3, 0)>(vb), h3 = tr_read<v_rd_off(D0, 3, 1)>(vb);
  asm volatile("s_waitcnt lgkmcnt(0)" ::: "memory"); SBAR();
#define PK(L, H) (bf16x8){L[0], L[1], L[2], L[3], H[0], H[1], H[2], H[3]}
  od = __builtin_amdgcn_mfma_f32_32x32x16_bf16(pa0, PK(l0, h0), od, 0, 0, 0);
  od = __builtin_amdgcn_mfma_f32_32x32x16_bf16(pa1, PK(l1, h1), od, 0, 0, 0);
  od = __builtin_amdgcn_mfma_f32_32x32x16_bf16(pa2, PK(l2, h2), od, 0, 0, 0);
  od = __builtin_amdgcn_mfma_f32_32x32x16_bf16(pa3, PK(l3, h3), od, 0, 0, 0);
#undef PK
}
__device__ __forceinline__ void pv_d0(f32x16* o, int vb, bf16x8 pa0, bf16x8 pa1, bf16x8 pa2, bf16x8 pa3) {
  pv_one<0>(o[0], vb, pa0, pa1, pa2, pa3); pv_one<1>(o[1], vb, pa0, pa1, pa2, pa3); pv_one<2>(o[2], vb, pa0, pa1, pa2, pa3); pv_one<3>(o[3], vb, pa0, pa1, pa2, pa3);
}

template <bool MLA>
__device__ __forceinline__ void attn_unit(const bf16_t* __restrict__ Qb, const bf16_t* __restrict__ Qrb, const bf16_t* __restrict__ Kh, const bf16_t* __restrict__ Krh,
                                          const bf16_t* __restrict__ Vh, bf16_t* Ob, char* lds, LAS unsigned char* ldsl) {
  constexpr int LDQ = LDQQ, LDO = LDQQ, LDK = MLA ? 2048 : LDQQ, LDKR = LDPB, NT = SEQ / KVBLK;
  const int tid = opaque_tid(), wid = __builtin_amdgcn_readfirstlane(tid >> 6), lane = tid & 63, r32 = lane & 31, hi = lane >> 5;
  char* V_lds = lds + OFF_V; char* K_lds = lds + OFF_K; char* KR_lds = lds + OFF_KR;
  float* ws = (float*)(lds + OFF_WS) + wid * 64; float* li_l = ws; float* al_l = ws + 32;
  unsigned koff[2], voff[2], kroff = 0;
#pragma unroll
  for (int i = 0; i < 2; ++i) { const int p = 2 * wid + i;
    { const int row = 4 * p + (lane >> 4), pc = lane & 15, c = pc ^ (row & 7); koff[i] = (unsigned)(row * LDK + c * 8) * 2u; }
    { const int o = p * 1024 + lane * 16, sub = o >> 9, w_ = (o & 511) >> 1, kk = (sub >> 2) * 8 + (w_ >> 5), k = (kk & ~0xC) | ((kk & 4) << 1) | ((kk & 8) >> 1), c = (sub & 3) * 32 + (w_ & 31);
      voff[i] = (unsigned)(k * LDK + c) * 2u; } }
  if constexpr (MLA) { const int row = 8 * wid + (lane >> 3), pc = lane & 7, ch = pc ^ ((row >> 1) & 7); kroff = (unsigned)(row * LDKR + ch * 8) * 2u; }
#define DMA_TILE(t, slot) do { const char* kb_ = (const char*)Kh + (size_t)(t) * (KVBLK * LDK * 2); const char* vb_ = (const char*)Vh + (size_t)(t) * (KVBLK * LDK * 2); \
    _Pragma("unroll") for (int i_ = 0; i_ < 2; ++i_) { \
      __builtin_amdgcn_global_load_lds((const unsigned*)(kb_ + koff[i_]), (LAS unsigned*)(ldsl + OFF_K + (slot) * SHM_K + (2 * wid + i_) * 1024), 16, 0, 0); \
      __builtin_amdgcn_global_load_lds((const unsigned*)(vb_ + voff[i_]), (LAS unsigned*)(ldsl + OFF_V + (slot) * SHM_V + (2 * wid + i_) * 1024), 16, 0, 0); } \
    if constexpr (MLA) __builtin_amdgcn_global_load_lds((const unsigned*)((const char*)Krh + (size_t)(t) * (KVBLK * LDKR * 2) + kroff), (LAS unsigned*)(ldsl + OFF_KR + (slot) * SHM_KR + wid * 1024), 16, 0, 0); } while (0)
#define WAIT_BAR() do { asm volatile("s_waitcnt vmcnt(0)" ::: "memory"); __syncthreads(); } while (0)
  DMA_TILE(0, 0); DMA_TILE(1, 1);
  float l_reg = 0, m_reg = 0; f32x16 o[4] = {}; bf16x8 qr[8]; f32x16 negm = {}; asm volatile("" : "+v"(negm));
  char* qrl = lds + OFF_QR + wid * 4096 + lane * 16;
  { const bf16_t* Qw = Qb + (long)(wid * QBLK + r32) * LDQ + hi * 8;
#pragma unroll
    for (int d0 = 0; d0 < 8; ++d0) qr[d0] = *reinterpret_cast<const bf16x8*>(Qw + d0 * 16);
    if constexpr (MLA) { const bf16_t* Qw2 = Qrb + (long)(wid * QBLK + r32) * LDQ + hi * 8;
#pragma unroll
      for (int d0 = 0; d0 < 4; ++d0) *reinterpret_cast<bf16x8*>(qrl + d0 * 1024) = *reinterpret_cast<const bf16x8*>(Qw2 + d0 * 16); } }
  const int vb0 = (int)(uintptr_t)V_lds + v_rd_base(lane);
#define RESC(a) do { if (__any((a) < 1.f)) { if (hi == 0) al_l[r32] = (a); asm volatile("s_waitcnt lgkmcnt(0)" ::: "memory"); \
    _Pragma("unroll") for (int d = 0; d < 4; ++d) _Pragma("unroll") for (int r = 0; r < 16; ++r) o[d][r] *= al_l[crow(r, hi)]; } } while (0)
  f32x16 pA0, pA1, pB0, pB1; float alA, alB; bf16x8 pa0, pa1, pa2, pa3;
  WAIT_BAR();
  qkt<MLA>(pA0, pA1, K_lds, KR_lds, qr, qrl, negm, r32, hi); partialSM<true, false>(pA0, pA1, negm, m_reg, alA);
  int s_prev = 0, s_cur = 1, s_next = 2;
#define ROT() do { const int t_ = s_prev; s_prev = s_cur; s_cur = s_next; s_next = t_; } while (0)
  for (int j = 1; j + 1 < NT; j += 2) {
    SBAR(); DMA_TILE(j + 1, s_next); SBAR();
    qkt<MLA>(pB0, pB1, K_lds + s_cur * SHM_K, KR_lds + s_cur * SHM_KR, qr, qrl, negm, r32, hi);
    finishSM(pA0, pA1, alA, l_reg, pa0, pa1, pa2, pa3);
    pv_d0(o, vb0 + s_prev * SHM_V, pa0, pa1, pa2, pa3); partialSM<false, false>(pB0, pB1, negm, m_reg, alB);
    RESC(alB); WAIT_BAR(); ROT();
    SBAR(); DMA_TILE(j + 2, s_next); SBAR();
    qkt<MLA>(pA0, pA1, K_lds + s_cur * SHM_K, KR_lds + s_cur * SHM_KR, qr, qrl, negm, r32, hi);
    finishSM(pB0, pB1, alB, l_reg, pa0, pa1, pa2, pa3);
    pv_d0(o, vb0 + s_prev * SHM_V, pa0, pa1, pa2, pa3); partialSM<false, false>(pA0, pA1, negm, m_reg, alA);
    RESC(alA); WAIT_BAR(); ROT();
  }
  SBAR(); qkt<MLA>(pB0, pB1, K_lds + s_cur * SHM_K, KR_lds + s_cur * SHM_KR, qr, qrl, negm, r32, hi);
  finishSM(pA0, pA1, alA, l_reg, pa0, pa1, pa2, pa3); SBAR();
  pv_d0(o, vb0 + s_prev * SHM_V, pa0, pa1, pa2, pa3); partialSM<false, false>(pB0, pB1, negm, m_reg, alB);
  RESC(alB);
  finishSM(pB0, pB1, alB, l_reg, pa0, pa1, pa2, pa3); SBAR();
  pv_d0(o, vb0 + s_cur * SHM_V, pa0, pa1, pa2, pa3);
  if (hi == 0) li_l[r32] = l_reg; asm volatile("s_waitcnt lgkmcnt(0)" ::: "memory");
  float rli[16];
#pragma unroll
  for (int r = 0; r < 16; ++r) rli[r] = __builtin_amdgcn_rcpf(li_l[crow(r, hi)]);
  bf16_t* Ow = Ob + (long)(wid * QBLK) * LDO;
#pragma unroll
  for (int r = 0; r < 16; ++r) { int orow = crow(r, hi);
#pragma unroll
    for (int d0 = 0; d0 < 4; ++d0) Ow[(long)orow * LDO + d0 * 32 + r32] = (bf16_t)(cvt_pk_bf16(o[d0][r] * rli[r], 0.f) & 0xffffu); }
  __syncthreads();
#undef DMA_TILE
#undef WAIT_BAR
#undef RESC
#undef ROT
}
}


#define XB_TMO      128
#define XB_XCNT(j)  (256  + 64 * (j))
#define XB_XSUB(j)  (1280 + 64 * (j))
#define XB_XGEN(j)  (2304 + 64 * (j))
#define XB_TOP      3328
#define XB_TOPGEN   3392
#define XCD_BAR_WORDS 3456
#define XB_SPIN_CAP (1u << 18)
__device__ __forceinline__ unsigned xb_ld(unsigned* p)              { return __hip_atomic_load(p, __ATOMIC_RELAXED, __HIP_MEMORY_SCOPE_AGENT); }
__device__ __forceinline__ unsigned xb_add(unsigned* p, unsigned v) { return __hip_atomic_fetch_add(p, v, __ATOMIC_RELAXED, __HIP_MEMORY_SCOPE_AGENT); }
__device__ __forceinline__ unsigned xb_xcc_id() { return (unsigned)__builtin_amdgcn_s_getreg((3 << 11) | 20) & 0xFu; }
#define XB_SPIN(cond, bar) do { unsigned _sp = 0; while (cond) { __builtin_amdgcn_s_sleep(1); \
    if ((++_sp & 255u) == 0u) { if (xb_ld(&(bar)[XB_TMO])) break; if (_sp > XB_SPIN_CAP) { atomicAdd(&(bar)[XB_TMO], 1u); break; } } } } while (0)
__device__ __forceinline__ void xcd_barrier_complete(unsigned* bar, unsigned x, unsigned& nloc, unsigned& nx) {
    const unsigned G = gridDim.x * gridDim.y * gridDim.z;
    unsigned sum, cnt, mine, sp = 0u;
    for (;;) {
        sum = 0u; cnt = 0u; mine = 0u;
#pragma unroll
        for (unsigned j = 0; j < 16; ++j) { const unsigned c = xb_ld(&bar[XB_XCNT(j)]); sum += c; cnt += (c > 0u) ? 1u : 0u; mine = (j == x) ? c : mine; }
        if (sum == G) break;
        __builtin_amdgcn_s_sleep(1);
        if ((++sp & 255u) == 0u) { if (xb_ld(&bar[XB_TMO])) break; if (sp > XB_SPIN_CAP) { atomicAdd(&bar[XB_TMO], 1u); break; } }
    }
    nloc = mine > 0u ? mine : 1u; nx = cnt > 0u ? cnt : 1u;
}
__device__ __forceinline__ void xcd_barrier(unsigned* bar, volatile LAS unsigned* st) {
    asm volatile("s_waitcnt vmcnt(0)" ::: "memory");
    __syncthreads();
    if (threadIdx.x == 0) {
        const unsigned x = xb_xcc_id();
        __builtin_amdgcn_s_waitcnt(0);
        unsigned nloc = st[0], nx = st[1];
        if (nloc == 0u) { xcd_barrier_complete(bar, x, nloc, nx); st[0] = nloc; st[1] = nx; }
        const unsigned old = xb_add(&bar[XB_XSUB(x)], 1u);
        const unsigned gen = old / nloc;
        if (old + 1u == (gen + 1u) * nloc) {
            __builtin_amdgcn_fence(__ATOMIC_RELEASE, "agent");
            asm volatile("s_waitcnt vmcnt(0)" ::: "memory");
            const unsigned og = xb_add(&bar[XB_TOP], 1u);
            const unsigned tg = og / nx;
            if (og + 1u == (tg + 1u) * nx) xb_add(&bar[XB_TOPGEN], 1u);
            else XB_SPIN(xb_ld(&bar[XB_TOPGEN]) == tg, bar);
            __builtin_amdgcn_fence(__ATOMIC_ACQUIRE, "agent");
            xb_add(&bar[XB_XGEN(x)], 1u);
            asm volatile("s_waitcnt vmcnt(0)" ::: "memory");
        } else {
            XB_SPIN(xb_ld(&bar[XB_XGEN(x)]) == gen, bar);
            __builtin_amdgcn_fence(__ATOMIC_ACQUIRE, "agent");
            asm volatile("s_waitcnt vmcnt(0)" ::: "memory");
        }
    }
    __syncthreads();
}

struct Params { const float* in[36]; float* out; unsigned char* ws; long ph_lo, ph_hi; };
constexpr int LDS_BYTES = 163840;

__device__ __forceinline__ int transpose_dst(int mode, int n0) {
    if (mode == 1) return (n0 >> 7) * 256 + (n0 & 127);
    if (mode == 2) return (n0 >> 7) * 256 + 128 + (n0 & 127);
    if (mode == 3) { const int h = n0 / 192, d0 = n0 % 192; return d0 < 128 ? h * 128 + d0 : 1024 + h * 64 + (d0 - 128); }
    return n0;
}
__device__ __forceinline__ void transpose_matrix(const float* W, int K, int N, bf16_t* WT, int ldt, int mode, int gw, int NGW, int lane, float wscale = 1.0f) {
    constexpr int NI = 4;
    const int nblk = N / 32, nitems = (K / 64) * nblk; const int kg = lane >> 3, nq = lane & 7;
    for (int it0 = gw; it0 < nitems; it0 += NGW * NI) {
        f32x4 v[NI][8];
#pragma unroll
        for (int q = 0; q < NI; ++q) { const int it = it0 + q * NGW; if (it < nitems) { const int kb = it / nblk, nb = it % nblk;
#pragma unroll
            for (int i = 0; i < 8; ++i) v[q][i] = *(const f32x4*)(W + (size_t)(64 * kb + 8 * kg + i) * N + 32 * nb + 4 * nq); } }
#pragma unroll
        for (int q = 0; q < NI; ++q) { const int it = it0 + q * NGW; if (it < nitems) { const int kb = it / nblk, nb = it % nblk, dst = transpose_dst(mode, 32 * nb);
#pragma unroll
            for (int c = 0; c < 4; ++c) { u32x4 o; o.x = cvt_pk_bf16(v[q][0][c] * wscale, v[q][1][c] * wscale); o.y = cvt_pk_bf16(v[q][2][c] * wscale, v[q][3][c] * wscale); o.z = cvt_pk_bf16(v[q][4][c] * wscale, v[q][5][c] * wscale); o.w = cvt_pk_bf16(v[q][6][c] * wscale, v[q][7][c] * wscale);
                *(u32x4*)(WT + (size_t)(dst + 4 * nq + c) * ldt + 64 * kb + 8 * kg) = o; } } }
    }
}
__device__ __forceinline__ const float* xin_row(const Params& p, int r) { return r < NPROMPT ? p.in[0] + (size_t)r * DM : p.in[1] + (size_t)(r - NPROMPT) * DM; }

__device__ __forceinline__ void prenorm_rows(const Params& p, const float* g, bf16_t* XN, int gw, int NGW, int lane) {
    f32x4 gg[8];
#pragma unroll
    for (int j = 0; j < 4; ++j) { gg[2 * j] = *(const f32x4*)(g + j * 512 + lane * 8); gg[2 * j + 1] = *(const f32x4*)(g + j * 512 + lane * 8 + 4); }
    for (int r0 = gw; r0 < T; r0 += 2 * NGW) {
        int rr[2]; rr[0] = r0; rr[1] = (r0 + NGW < T) ? r0 + NGW : r0;
        f32x4 v[2][8];
#pragma unroll
        for (int k = 0; k < 2; ++k) { const float* xr = xin_row(p, rr[k]);
#pragma unroll
            for (int j = 0; j < 4; ++j) { v[k][2 * j] = *(const f32x4*)(xr + j * 512 + lane * 8); v[k][2 * j + 1] = *(const f32x4*)(xr + j * 512 + lane * 8 + 4); } }
#pragma unroll
        for (int k = 0; k < 2; ++k) { float ss = 0.f;
#pragma unroll
            for (int j = 0; j < 8; ++j) ss += (v[k][j].x * v[k][j].x + v[k][j].y * v[k][j].y) + (v[k][j].z * v[k][j].z + v[k][j].w * v[k][j].w);
            const float rstd = rsqrtf(wave_sum(ss) * (1.f / DM) + EPS);
#pragma unroll
            for (int j = 0; j < 4; ++j) { const f32x4 a = v[k][2 * j] * rstd * gg[2 * j], b = v[k][2 * j + 1] * rstd * gg[2 * j + 1];
                u32x4 w; w.x = cvt_pk_bf16(a.x, a.y); w.y = cvt_pk_bf16(a.z, a.w); w.z = cvt_pk_bf16(b.x, b.y); w.w = cvt_pk_bf16(b.z, b.w);
                *(u32x4*)(XN + (size_t)rr[k] * DM + j * 512 + lane * 8) = w; } }
    }
}
__device__ __forceinline__ f32x4 ylo(const u32x4 w) { return (f32x4){bflo(w.x), bfhi(w.x), bflo(w.y), bfhi(w.y)}; }
__device__ __forceinline__ f32x4 yhi(const u32x4 w) { return (f32x4){bflo(w.z), bfhi(w.z), bflo(w.w), bfhi(w.w)}; }
__device__ __forceinline__ float sq4(const f32x4 t) { return (t.x * t.x + t.y * t.y) + (t.z * t.z + t.w * t.w); }
__device__ __forceinline__ void resid_rows(const Params& p, const bf16_t* Y, const float* cs, const float* post_g, float alpha, bool first, const float* next_g, bf16_t* XN, bf16_t* X16,
                                           int gw, int NGW, int lane) {
    const bool last = (next_g == nullptr);
    f32x4 pg[8], ng[8];
#pragma unroll
    for (int j = 0; j < 4; ++j) { pg[2 * j] = *(const f32x4*)(post_g + j * 512 + lane * 8); pg[2 * j + 1] = *(const f32x4*)(post_g + j * 512 + lane * 8 + 4); }
    if (cs) {
#pragma unroll
        for (int j = 0; j < 4; ++j) { pg[2 * j] *= *(const f32x4*)(cs + j * 512 + lane * 8); pg[2 * j + 1] *= *(const f32x4*)(cs + j * 512 + lane * 8 + 4); }
    }
    if (next_g) {
#pragma unroll
        for (int j = 0; j < 4; ++j) { ng[2 * j] = *(const f32x4*)(next_g + j * 512 + lane * 8); ng[2 * j + 1] = *(const f32x4*)(next_g + j * 512 + lane * 8 + 4); }
    }
    for (int r = gw; r < T; r += NGW) {
        u32x4 yw[4]; f32x4 xv[8];
#pragma unroll
        for (int j = 0; j < 4; ++j) yw[j] = __builtin_nontemporal_load((const u32x4*)(Y + (size_t)r * DM + j * 512 + lane * 8));
        if (first) { const float* xr = xin_row(p, r);
#pragma unroll
            for (int j = 0; j < 4; ++j) { xv[2 * j] = *(const f32x4*)(xr + j * 512 + lane * 8); xv[2 * j + 1] = *(const f32x4*)(xr + j * 512 + lane * 8 + 4); }
        } else { u32x4 xw[4];
#pragma unroll
            for (int j = 0; j < 4; ++j) xw[j] = __builtin_nontemporal_load((const u32x4*)(X16 + (size_t)r * DM + j * 512 + lane * 8));
#pragma unroll
            for (int j = 0; j < 4; ++j) { xv[2 * j] = ylo(xw[j]); xv[2 * j + 1] = yhi(xw[j]); }
        }
        float ss = 0.f;
        if (cs) {
#pragma unroll
            for (int j = 0; j < 4; ++j) ss += sq4(ylo(yw[j]) * *(const f32x4*)(cs + j * 512 + lane * 8)) + sq4(yhi(yw[j]) * *(const f32x4*)(cs + j * 512 + lane * 8 + 4));
        } else {
#pragma unroll
            for (int j = 0; j < 4; ++j) ss += sq4(ylo(yw[j])) + sq4(yhi(yw[j]));
        }
        const float rs = alpha * rsqrtf(wave_sum(ss) * (1.f / DM) + EPS); float ss2 = 0.f;
#pragma unroll
        for (int j = 0; j < 4; ++j) { xv[2 * j] += (ylo(yw[j]) * rs) * pg[2 * j]; xv[2 * j + 1] += (yhi(yw[j]) * rs) * pg[2 * j + 1]; ss2 += sq4(xv[2 * j]) + sq4(xv[2 * j + 1]); }
        if (last) { float* xo = p.out + (size_t)r * DM;
#pragma unroll
            for (int j = 0; j < 4; ++j) { __builtin_nontemporal_store(xv[2 * j], (f32x4*)(xo + j * 512 + lane * 8)); __builtin_nontemporal_store(xv[2 * j + 1], (f32x4*)(xo + j * 512 + lane * 8 + 4)); }
        } else {
#pragma unroll
            for (int j = 0; j < 4; ++j) { const f32x4 a = xv[2 * j], b = xv[2 * j + 1];
                u32x4 w; w.x = cvt_pk_bf16(a.x, a.y); w.y = cvt_pk_bf16(a.z, a.w); w.z = cvt_pk_bf16(b.x, b.y); w.w = cvt_pk_bf16(b.z, b.w);
                *(u32x4*)(X16 + (size_t)r * DM + j * 512 + lane * 8) = w; }
            const float r2 = rsqrtf(wave_sum(ss2) * (1.f / DM) + EPS);
#pragma unroll
            for (int j = 0; j < 4; ++j) { const f32x4 a = (xv[2 * j] * r2) * ng[2 * j], b = (xv[2 * j + 1] * r2) * ng[2 * j + 1];
                u32x4 w; w.x = cvt_pk_bf16(a.x, a.y); w.y = cvt_pk_bf16(a.z, a.w); w.z = cvt_pk_bf16(b.x, b.y); w.w = cvt_pk_bf16(b.z, b.w);
                *(u32x4*)(XN + (size_t)r * DM + j * 512 + lane * 8) = w; }
        }
    }
}
__device__ __forceinline__ void rope_cs(float ang, float& c, float& s) {
    float rev = ang * 0.15915494309189535f; rev -= rintf(rev);
    c = __builtin_amdgcn_cosf(rev); s = __builtin_amdgcn_sinf(rev);
}
__device__ __forceinline__ void qknorm_rows(const Params& p, bf16_t* QQ, bf16_t* PB, int gw, int NGW, int lane) {
    const float* gq = p.in[9]; const float* gk = p.in[10]; const float* gcq = p.in[11]; const float* gckv = p.in[13];
    const float gq0 = gq[2 * lane], gq1 = gq[2 * lane + 1], gk0 = gk[2 * lane], gk1 = gk[2 * lane + 1];
    float gc[12];
#pragma unroll
    for (int j = 0; j < 4; ++j) { gc[2 * j] = gcq[j * 128 + 2 * lane]; gc[2 * j + 1] = gcq[j * 128 + 2 * lane + 1]; }
#pragma unroll
    for (int j = 0; j < 2; ++j) { gc[8 + 2 * j] = gckv[j * 128 + 2 * lane]; gc[9 + 2 * j] = gckv[j * 128 + 2 * lane + 1]; }
    const float fA = __builtin_amdgcn_exp2f(-(float)(lane & 31) * (13.287712379549449f / 32.f));
    const float fB = __builtin_amdgcn_exp2f(-(float)(lane & 15) * (13.287712379549449f / 16.f));
    for (int r = gw; r < T; r += NGW) {
        const int s = r & (SEQ - 1), ri = s >> 6, ci = s & 63;
        bf16_t* q = QQ + (size_t)r * LDQQ; bf16_t* pb = PB + (size_t)r * LDPB;
        unsigned wq[10], wp[6], wk = 0u;
#pragma unroll
        for (int h = 0; h < 10; ++h) wq[h] = *(const unsigned*)(q + (h < 8 ? h * 128 : 2560 + (h - 8) * 128) + 2 * lane);
#pragma unroll
        for (int j = 0; j < 6; ++j) wp[j] = *(const unsigned*)(pb + j * 128 + 2 * lane);
        if (lane < 32) wk = *(const unsigned*)(pb + 768 + 2 * lane);
        float cA, sA, cB, sB; rope_cs((float)(lane < 32 ? ri : ci) * fA, cA, sA); rope_cs((float)((lane & 31) < 16 ? ri : ci) * fB, cB, sB);
        unsigned oq[10], op[6];
#pragma unroll
        for (int h = 0; h < 10; ++h) {
            float a = bflo(wq[h]), b = bfhi(wq[h]);
            const float rstd = rsqrtf(wave_sum(a * a + b * b) * (1.f / 128.f) + EPS);
            a = a * rstd * (h < 8 ? gq0 : gk0); b = b * rstd * (h < 8 ? gq1 : gk1);
            const float qs = h < 8 ? 0.12751743f : 1.0f;
            oq[h] = cvt_pk_bf16((a * cA - b * sA) * qs, (a * sA + b * cA) * qs);
        }
        { float ss = 0.f;
#pragma unroll
          for (int j = 0; j < 4; ++j) ss += bflo(wp[j]) * bflo(wp[j]) + bfhi(wp[j]) * bfhi(wp[j]);
          const float rstd = rsqrtf(wave_sum(ss) * (1.f / 512.f) + EPS);
#pragma unroll
          for (int j = 0; j < 4; ++j) op[j] = cvt_pk_bf16(bflo(wp[j]) * rstd * gc[2 * j], bfhi(wp[j]) * rstd * gc[2 * j + 1]); }
        { float ss = 0.f;
#pragma unroll
          for (int j = 4; j < 6; ++j) ss += bflo(wp[j]) * bflo(wp[j]) + bfhi(wp[j]) * bfhi(wp[j]);
          const float rstd = rsqrtf(wave_sum(ss) * (1.f / 256.f) + EPS);
#pragma unroll
          for (int j = 4; j < 6; ++j) op[j] = cvt_pk_bf16(bflo(wp[j]) * rstd * gc[2 * j], bfhi(wp[j]) * rstd * gc[2 * j + 1]); }
#pragma unroll
        for (int h = 0; h < 10; ++h) *(unsigned*)(q + (h < 8 ? h * 128 : 2560 + (h - 8) * 128) + 2 * lane) = oq[h];
#pragma unroll
        for (int j = 0; j < 6; ++j) *(unsigned*)(pb + j * 128 + 2 * lane) = op[j];
        if (lane < 32) { const float a = bflo(wk), b = bfhi(wk); *(unsigned*)(pb + 768 + 2 * lane) = cvt_pk_bf16(a * cB - b * sB, a * sB + b * cB); }
    }
}
__device__ __forceinline__ void qrope_rows(bf16_t* QQ, int gw, int NGW, int lane) {
    const float fB = __builtin_amdgcn_exp2f(-(float)(lane & 15) * (13.287712379549449f / 16.f));
    for (int r0 = gw; r0 < T; r0 += 2 * NGW) {
        unsigned w[2][4]; const int r1 = r0 + NGW;
#pragma unroll
        for (int j = 0; j < 4; ++j) { w[0][j] = *(const unsigned*)(QQ + (size_t)r0 * LDQQ + 2048 + j * 128 + 2 * lane); if (r1 < T) w[1][j] = *(const unsigned*)(QQ + (size_t)r1 * LDQQ + 2048 + j * 128 + 2 * lane); }
#pragma unroll
        for (int k = 0; k < 2; ++k) { const int r = k ? r1 : r0; if (r < T) {
            const int s = r & (SEQ - 1), ri = s >> 6, ci = s & 63;
            float cB, sB; rope_cs((float)((lane & 31) < 16 ? ri : ci) * fB, cB, sB);
#pragma unroll
            for (int j = 0; j < 4; ++j) { const float a = bflo(w[k][j]), b = bfhi(w[k][j]);
                *(unsigned*)(QQ + (size_t)r * LDQQ + 2048 + j * 128 + 2 * lane) = cvt_pk_bf16(a * cB - b * sB, a * sB + b * cB); } } }
    }
}
template <int J> __device__ __forceinline__ void pool_group(const bf16_t* XN, bf16_t* POOL, int r, int s, size_t base, int lane) {
    constexpr int hw = 1 << J, W = 2 * hw;
    const int lo = (s - hw) < 0 ? 0 : (s - hw), hi = (s + hw) > SEQ ? SEQ : (s + hw);
    u32x4 w[W];
#pragma unroll
    for (int i = 0; i < W; ++i) { int t = s - hw + i; t = t < 0 ? 0 : (t >= SEQ ? SEQ - 1 : t); w[i] = *(const u32x4*)(XN + (base + t) * DM + J * 512 + lane * 8); }
    float a[8] = {0.f, 0.f, 0.f, 0.f, 0.f, 0.f, 0.f, 0.f};
#pragma unroll
    for (int i = 0; i < W; ++i) { const int t = s - hw + i; const float f = (t >= 0 && t < SEQ) ? 1.f : 0.f;
        a[0] += f * bflo(w[i].x); a[1] += f * bfhi(w[i].x); a[2] += f * bflo(w[i].y); a[3] += f * bfhi(w[i].y); a[4] += f * bflo(w[i].z); a[5] += f * bfhi(w[i].z); a[6] += f * bflo(w[i].w); a[7] += f * bfhi(w[i].w); }
    const float inv = 1.0f / (float)(hi - lo);
    const u32x4 x = w[hw];
    u32x4 o; o.x = cvt_pk_bf16(a[0] * inv - bflo(x.x), a[1] * inv - bfhi(x.x)); o.y = cvt_pk_bf16(a[2] * inv - bflo(x.y), a[3] * inv - bfhi(x.y));
    o.z = cvt_pk_bf16(a[4] * inv - bflo(x.z), a[5] * inv - bfhi(x.z)); o.w = cvt_pk_bf16(a[6] * inv - bflo(x.w), a[7] * inv - bfhi(x.w));
    *(u32x4*)(POOL + (size_t)r * DM + J * 512 + lane * 8) = o;
}
__device__ __forceinline__ void pool_rows(const bf16_t* XN, bf16_t* POOL, int gw, int NGW, int lane) {
    for (int r = gw; r < T; r += NGW) {
        const int s = r & (SEQ - 1); const size_t base = (size_t)(r - s);
        pool_group<0>(XN, POOL, r, s, base, lane); pool_group<1>(XN, POOL, r, s, base, lane); pool_group<2>(XN, POOL, r, s, base, lane); pool_group<3>(XN, POOL, r, s, base, lane);
    }
}

#ifndef NDUP
#define NDUP 0
#define DUP_LIST {0}
#endif
__device__ __forceinline__ int slot_phase(int s) { constexpr int d[NDUP + 1] = DUP_LIST; int ph = s;
#pragma unroll
    for (int i = 0; i < NDUP; ++i) ph -= (s > d[i] + i) ? 1 : 0;
    return ph; }
enum { K_PRO = 0, K_GU, K_PLAIN, K_RESID, K_QKN, K_QROPE, K_ATT, K_POOL };
constexpr int NPHASE = 23;

__global__ void __launch_bounds__(512) mega_fwd(Params p) {
    extern __shared__ __attribute__((aligned(16))) unsigned char lds[];
    cg::grid_group grid = cg::this_grid();
    volatile LAS unsigned* xst = (volatile LAS unsigned*)((LAS unsigned char*)lds + LDS_BYTES - 64);
    if (threadIdx.x == 0) { xst[0] = 0u; xst[1] = 0u; (void)xb_add(&((unsigned*)p.ws)[XB_XCNT(xb_xcc_id())], 1u); }
    __syncthreads();
    for (int slot = (int)p.ph_lo; slot < (int)p.ph_hi; ++slot) {
        const int ph = slot_phase(slot);
        int G = gridDim.x, bx = blockIdx.x; asm volatile("" : "+s"(G), "+s"(bx));
        const int NGW = G * 8;
        size_t zoff = 0; asm volatile("" : "+s"(zoff));
        unsigned char* ws = p.ws + zoff;
        bf16_t* XN = (bf16_t*)(ws + WS_XN); bf16_t* Hb = (bf16_t*)(ws + WS_H); bf16_t* QQ = (bf16_t*)(ws + WS_QQ); bf16_t* PB = (bf16_t*)(ws + WS_PB);
        bf16_t* MIX = (bf16_t*)(ws + WS_MIX); bf16_t* POOL = (bf16_t*)(ws + WS_POOL); bf16_t* KVb = XN;
        unsigned char* ob = (unsigned char*)p.out + zoff;
        unsigned char* mixw = ob + OUT_MIXW;
        bf16_t* Win_t = (bf16_t*)(mixw + OFF_WIN); bf16_t* Wuq_t = (bf16_t*)(mixw + OFF_WUQ); bf16_t* Wukv_t = (bf16_t*)(mixw + OFF_WUKV); bf16_t* Wout_t = (bf16_t*)(mixw + OFF_WOUT); bf16_t* Wpool_t = (bf16_t*)(mixw + OFF_WPOOL);
        bf16_t* X16 = (bf16_t*)(ws + WS_X16);
        int kind = K_PRO, fs = 0, ngemm = 1;
        const int tid = opaque_tid(), lane = tid & 63, wave = __builtin_amdgcn_readfirstlane(tid >> 6), gw = bx * 8 + wave;
        if (ph == 0) kind = K_PRO;
        else if (ph == 1 || ph == 11 || ph == 14 || ph == 20) { kind = K_GU; fs = ph == 1 ? 0 : ph == 11 ? 1 : ph == 14 ? 2 : 3; }
        else if (ph == 2 || ph == 12 || ph == 15 || ph == 21) { kind = K_PLAIN; fs = ph == 2 ? 0 : ph == 12 ? 1 : ph == 15 ? 2 : 3; }
        else if (ph == 3 || ph == 13 || ph == 16 || ph == 22 || ph == 10 || ph == 19) kind = K_RESID;
        else if (ph == 4 || ph == 9 || ph == 18) kind = K_PLAIN;
        else if (ph == 6) { kind = K_PLAIN; ngemm = 2; }
        else if (ph == 5) kind = K_QKN;
        else if (ph == 7) kind = K_QROPE;
        else if (ph == 8) kind = K_ATT;
        else if (ph == 17) kind = K_POOL;

        if (kind == K_PRO) {
            for (int s = 0; s < 4; ++s) {
                const int b = s == 0 ? 2 : s == 1 ? 17 : s == 2 ? 22 : 31;
                unsigned char* wb = s < 3 ? ob + (size_t)s * FFN_W_BYTES : ws + WS_W3; bf16_t* Wgu = (bf16_t*)wb; bf16_t* Wd = (bf16_t*)(wb + WGU_BYTES);
                transpose_matrix(p.in[b + 1], DM, DFF, Wgu, DM, 1, gw, NGW, lane);
                transpose_matrix(p.in[b + 2], DM, DFF, Wgu, DM, 2, gw, NGW, lane);
                transpose_matrix(p.in[b + 3], DFF, DM, Wd, DFF, 0, gw, NGW, lane);
            }
            transpose_matrix(p.in[8], DM, 2368, Win_t, DM, 0, gw, NGW, lane);
            for (int i = gw * 64 + lane; i < (2560 - 2368) * DM / 8; i += NGW * 64) *(u32x4*)(Win_t + (size_t)2368 * DM + (size_t)i * 8) = (u32x4){0u, 0u, 0u, 0u};
            transpose_matrix(p.in[12], 512, 1536, Wuq_t, 512, 3, gw, NGW, lane, 0.10411755f);
            transpose_matrix(p.in[14], 256, 2048, Wukv_t, 256, 0, gw, NGW, lane);
            transpose_matrix(p.in[15], 2048, 2048, Wout_t, 2048, 0, gw, NGW, lane);
            for (int gi = 0; gi < 4; ++gi) transpose_matrix(p.in[28] + (size_t)gi * 512 * 512, 512, 512, Wpool_t + (size_t)gi * 512 * 512, 512, 0, gw, NGW, lane);
            prenorm_rows(p, p.in[2], XN, gw, NGW, lane);
        } else if (kind == K_GU) {
            bf16_t* Wgu = (bf16_t*)(fs < 3 ? ob + (size_t)fs * FFN_W_BYTES : ws + WS_W3);
            pg8::Gemm g{XN, Wgu, DM, DM, T, 2 * DFF, DM, 0}; pg8::StaticOrder S; S.init(T, 2 * DFF, G, bx);
            pg8::EpiSwiGLU E{Hb, DFF};
            pg8::gemm_phase<pg8::EpiSwiGLU>((LAS unsigned char*)lds, g, S, E);
        } else if (kind == K_PLAIN) {
            for (int q = 0; q < ngemm; ++q) {
                pg8::Gemm g; pg8::EpiBf16 E{nullptr, 0, 0, 0, nullptr, 0};
                if (ph == 4) { g = pg8::Gemm{XN, Win_t, DM, DM, T, 2560, DM, 0}; E = pg8::EpiBf16{QQ, LDQQ, 0, 1, PB, LDPB}; }
                else if (ph == 6 && q == 0) { g = pg8::Gemm{PB, Wuq_t, LDPB, 512, T, 1536, 512, 0}; E = pg8::EpiBf16{QQ, LDQQ, 1024, 0, nullptr, 0}; }
                else if (ph == 6) { g = pg8::Gemm{PB + 512, Wukv_t, LDPB, 256, T, 2048, 256, 0}; E = pg8::EpiBf16{KVb, DM, 0, 0, nullptr, 0}; }
                else if (ph == 9) { g = pg8::Gemm{QQ, Wout_t, LDQQ, DM, T, DM, DM, 0}; E = pg8::EpiBf16{MIX, DM, 0, 0, nullptr, 0}; }
                else if (ph == 18) { g = pg8::Gemm{POOL, Wpool_t, DM, 512, T, DM, 512, 2}; E = pg8::EpiBf16{MIX, DM, 0, 0, nullptr, 0}; }
                else { bf16_t* Wd = (bf16_t*)((fs < 3 ? ob + (size_t)fs * FFN_W_BYTES : ws + WS_W3) + WGU_BYTES); g = pg8::Gemm{Hb, Wd, DFF, DFF, T, DM, DFF, 0}; E = pg8::EpiBf16{XN, DM, 0, 0, nullptr, 0}; }
                pg8::StaticOrder S; S.init(T, g.N, G, bx, (g.N == DM) ? 4 : 8);
                pg8::gemm_phase<pg8::EpiBf16>((LAS unsigned char*)lds, g, S, E);
            }
        } else if (kind == K_RESID) {
            const bf16_t* Y; const float* cs = nullptr; const float* post; const float* next; float alpha = 0.5f; bool first = false;
            if (ph == 3) { Y = XN; post = p.in[6]; next = p.in[7]; first = true; }
            else if (ph == 10) { Y = MIX; post = p.in[16]; next = p.in[17]; alpha = 1.f; }
            else if (ph == 13) { Y = XN; post = p.in[21]; next = p.in[22]; }
            else if (ph == 16) { Y = XN; post = p.in[26]; next = p.in[27]; }
            else if (ph == 19) { Y = MIX; cs = p.in[29]; post = p.in[30]; next = p.in[31]; alpha = 1.f; }
            else { Y = XN; post = p.in[35]; next = nullptr; }
            resid_rows(p, Y, cs, post, alpha, first, next, XN, X16, gw, NGW, lane);
        } else if (kind == K_QKN) {
            qknorm_rows(p, QQ, PB, gw, NGW, lane);
        } else if (kind == K_QROPE) {
            qrope_rows(QQ, gw, NGW, lane);
        } else if (kind == K_ATT) {
            for (int u = bx; u < 3072; u += G) {
                const int mla = u / 1536, v = u % 1536, grp = v >> 8, w = v & 255, bh = grp * 8 + (w & 7), qb = w >> 3, b = bh >> 3, h = bh & 7;
                const size_t row0 = (size_t)b * SEQ, q0 = row0 + (size_t)qb * 256;
                if (!mla) {
                    att::attn_unit<false>(QQ + q0 * LDQQ + h * 128, nullptr, QQ + row0 * LDQQ + 2560 + (h >> 2) * 128, nullptr, QQ + row0 * LDQQ + 2816 + (h >> 2) * 128,
                                          QQ + q0 * LDQQ + h * 128, (char*)lds, (LAS unsigned char*)lds);
                } else {
                    att::attn_unit<true>(QQ + q0 * LDQQ + 1024 + h * 128, QQ + q0 * LDQQ + 2048 + h * 64, KVb + row0 * DM + h * 256, PB + row0 * LDPB + 768, KVb + row0 * DM + h * 256 + 128,
                                         QQ + q0 * LDQQ + 1024 + h * 128, (char*)lds, (LAS unsigned char*)lds);
                }
            }
        } else if (kind == K_POOL) {
            pool_rows(XN, POOL, gw, NGW, lane);
        }
        if (slot + 1 < (int)p.ph_hi) { if (slot == 0) grid.sync(); else xcd_barrier((unsigned*)ws, xst); }
    }
}

extern "C" void kernel_launch(void* const* d_in, const int* in_sizes, int n_in, void* d_out, int out_size, void* d_ws, size_t ws_size, hipStream_t stream) {
    static int grid = 0;
    if (grid == 0) {
        if (n_in != 36 || ws_size < WS_END || out_size != T * DM) { fprintf(stderr, "kernel_launch: unexpected shapes n_in %d ws %zu out %d\n", n_in, ws_size, out_size); grid = -1; return; }
        int dev = 0, cus = 0, per_cu = 0;
        hipGetDevice(&dev); hipDeviceGetAttribute(&cus, hipDeviceAttributeMultiprocessorCount, dev);
        hipFuncSetAttribute((const void*)mega_fwd, hipFuncAttributeMaxDynamicSharedMemorySize, LDS_BYTES);
        hipOccupancyMaxActiveBlocksPerMultiprocessor(&per_cu, (const void*)mega_fwd, 512, LDS_BYTES);
        if (per_cu < 1) per_cu = 1;
        if (per_cu > 1) per_cu = 1;
        grid = cus * per_cu;
        fprintf(stderr, "kernel_launch: grid %d (cus %d) ws %zu\n", grid, cus, ws_size);
    }
    if (grid < 0) return;
    if (hipMemsetAsync(d_ws, 0, 16384, stream) != hipSuccess) { fprintf(stderr, "kernel_launch: memset failed\n"); return; }
    Params p{};
    for (int i = 0; i < 36; ++i) p.in[i] = (const float*)d_in[i];
    p.out = (float*)d_out; p.ws = (unsigned char*)d_ws; p.ph_lo = 0; p.ph_hi = NPHASE + NDUP;
    void* args[] = {&p};
    hipError_t e = hipLaunchCooperativeKernel((const void*)mega_fwd, dim3(grid), dim3(512), args, LDS_BYTES, stream);
    if (e != hipSuccess) fprintf(stderr, "cooperative launch failed: %s (grid %d)\n", hipGetErrorString(e), grid);
}
```

```cpp
#include <hip/hip_runtime.h>
#include <hip/hip_cooperative_groups.h>
#include <cstdio>
#include <cstdint>
namespace cg = cooperative_groups;

#define LAS __attribute__((address_space(3)))
typedef unsigned short bf16_t;
typedef short bf16x8 __attribute__((ext_vector_type(8)));
typedef short s16x4 __attribute__((ext_vector_type(4)));
typedef float f32x4 __attribute__((ext_vector_type(4)));
typedef float f32x16 __attribute__((ext_vector_type(16)));
typedef unsigned u32x4 __attribute__((ext_vector_type(4)));
typedef unsigned u32x2 __attribute__((ext_vector_type(2)));

constexpr int T = 49152, DM = 2048, DFF = 5632, SEQ = 8192, NPROMPT = 16384;
constexpr float EPS = 1e-6f;
constexpr size_t MiB = 1u << 20;
constexpr size_t FFN_W_BYTES = 66 * MiB, WGU_BYTES = 44 * MiB;
constexpr size_t WS_W3 = 1 * MiB;
constexpr size_t OUT_MIXW = 198 * MiB;
constexpr size_t OFF_WIN = 0, OFF_WUQ = 10 * MiB, OFF_WUKV = OFF_WUQ + 3 * MiB / 2, OFF_WOUT = OFF_WUKV + 1 * MiB, OFF_WPOOL = OFF_WOUT + 8 * MiB;
constexpr size_t WS_XN = 67 * MiB;
constexpr size_t WS_X16 = 259 * MiB;
constexpr size_t WS_H = 451 * MiB;
constexpr size_t WS_QQ = WS_H, WS_PB = WS_H + 288 * MiB, WS_MIX = WS_H + 288 * MiB, WS_POOL = WS_H;
constexpr size_t WS_END = 979 * MiB;
constexpr int LDQQ = 3072, LDPB = 1024;

__device__ __forceinline__ unsigned cvt_pk_bf16(float lo, float hi) { unsigned r; asm volatile("v_cvt_pk_bf16_f32 %0, %1, %2" : "=v"(r) : "v"(lo), "v"(hi)); return r; }
typedef float f32x2_t __attribute__((ext_vector_type(2))); typedef __bf16 bf16x2_t __attribute__((ext_vector_type(2)));
__device__ __forceinline__ unsigned cvt_pk_s(float lo, float hi) { f32x2_t v = {lo, hi}; bf16x2_t b = __builtin_convertvector(v, bf16x2_t); return __builtin_bit_cast(unsigned, b); }
__device__ __forceinline__ float bflo(unsigned w) { return __uint_as_float(w << 16); }
__device__ __forceinline__ float bfhi(unsigned w) { return __uint_as_float(w & 0xffff0000u); }
__device__ __forceinline__ int opaque_tid() { int t = threadIdx.x; asm volatile("" : "+v"(t)); return t; }
__device__ __forceinline__ float wave_sum(float v) {
#pragma unroll
    for (int o = 1; o < 64; o <<= 1) v += __shfl_xor(v, o);
    return v;
}

__device__ __forceinline__ void rope_cs(float ang, float& c, float& s) {
    float rev = ang * 0.15915494309189535f; rev -= rintf(rev);
    c = __builtin_amdgcn_cosf(rev); s = __builtin_amdgcn_sinf(rev);
}

namespace pg8 {
constexpr int BM = 256, BK = 64, HALF = 128, HTB = HALF * BK * 2, STAGE_BYTES = 8 * HTB, NXCD = 8;
__host__ __device__ __forceinline__ int lds_byte(int r, int c) { const int st = (r >> 4) * 2 + (c >> 5), rr = r & 15, cc = c & 31, ob = rr * 64 + cc * 2; return st * 1024 + (ob ^ (((ob >> 9) & 1) << 5)); }
__host__ __device__ __forceinline__ void stage_rc(int b, int& R, int& C) { const int st = b / 1024, sb = b % 1024, swz = sb ^ (((sb >> 9) & 1) << 5); R = (st >> 1) * 16 + swz / 64; C = (st & 1) * 32 + (swz % 64) / 2; }
__host__ __device__ __forceinline__ int perm32(int rho) { const int n = rho >> 4, i = rho & 15; return 8 * (i >> 2) + 4 * n + (i & 3); }

struct Unit { int pm, pn; };
struct Gemm { const bf16_t* A; const bf16_t* Bt; int lda, ldb, M, N, K, agrp; };

struct StaticOrder {
    int nM, nN, nwg, G, c, WGM;
    __device__ void init(int M, int N, int G_, int c_, int wgm = 8) { nM = M / BM; nN = N / BM; nwg = nM * nN; G = G_; c = c_; WGM = wgm; }
    __device__ bool next(int i, Unit& u) const {
        const long L = (long)i * G + c; if (L >= nwg) return false;
        int wgid = (int)L; { const int q = nwg / NXCD, r = nwg % NXCD, xcd = wgid % NXCD, off = wgid / NXCD; wgid = (xcd < r ? xcd * (q + 1) : r * (q + 1) + (xcd - r) * q) + off; }
        const int nig = WGM * nN, gid = wgid / nig, fm = gid * WGM, gsz = (nM - fm) < WGM ? (nM - fm) : WGM;
        u.pm = fm + ((wgid % nig) % gsz); u.pn = (wgid % nig) / gsz; return true;
    }
};

struct EpiBf16 {
    static constexpr bool PERM = true;
    bf16_t* O; int ldc; int coloff; int mode; bf16_t* O2; int ldc2;
    __device__ __forceinline__ void operator()(const f32x4 (&acc)[2][2][4][2], const Unit& u, int wr, int wc, int fr, int fq) const {
        const int row0 = u.pm * BM + wr * 64 + fr; int colt = u.pn * BM + coloff; bf16_t* base = O; int ld = ldc;
        if (mode == 1) { if (u.pn < 4) colt = u.pn * 256; else if (u.pn < 6) colt = 2560 + (u.pn - 4) * 256; else { base = O2; ld = ldc2; colt = (u.pn - 6) * 256; } }
        const int col0 = colt + wc * 32 + 8 * fq;
        const bool rope = (mode == 2) && (u.pn >= 4);
        float rf[2][4];
#pragma unroll
        for (int bj = 0; bj < 2; ++bj)
#pragma unroll
            for (int k = 0; k < 4; ++k) rf[bj][k] = __builtin_amdgcn_exp2f(-(float)(((((bj * HALF + wc * 32 + 8 * fq) & 63) >> 1) & 15) + k) * (13.287712379549449f / 16.f));
#pragma unroll
        for (int ai = 0; ai < 2; ++ai)
#pragma unroll
            for (int m = 0; m < 4; ++m) { bf16_t* rowp = base + (size_t)(row0 + ai * HALF + m * 16) * ld + col0;
#pragma unroll
                for (int bj = 0; bj < 2; ++bj) { f32x4 v0 = acc[ai][bj][m][0], v1 = acc[ai][bj][m][1];
                    if (rope) {
                        const int sq = (row0 + ai * HALF + m * 16) & 8191; const int cl = (u.pn - 4) * BM + bj * HALF + wc * 32 + 8 * fq, i0 = (cl & 63) >> 1;
                        const float pos = (float)(i0 < 16 ? (sq >> 6) : (sq & 63));
                        float c_, s_;
                        rope_cs(pos * rf[bj][0], c_, s_); { const float a = v0[0], b = v0[1]; v0[0] = a * c_ - b * s_; v0[1] = a * s_ + b * c_; }
                        rope_cs(pos * rf[bj][1], c_, s_); { const float a = v0[2], b = v0[3]; v0[2] = a * c_ - b * s_; v0[3] = a * s_ + b * c_; }
                        rope_cs(pos * rf[bj][2], c_, s_); { const float a = v1[0], b = v1[1]; v1[0] = a * c_ - b * s_; v1[1] = a * s_ + b * c_; }
                        rope_cs(pos * rf[bj][3], c_, s_); { const float a = v1[2], b = v1[3]; v1[2] = a * c_ - b * s_; v1[3] = a * s_ + b * c_; } }
                    u32x4 w; w.x = cvt_pk_s(v0[0], v0[1]); w.y = cvt_pk_s(v0[2], v0[3]); w.z = cvt_pk_s(v1[0], v1[1]); w.w = cvt_pk_s(v1[2], v1[3]);
                    *(u32x4*)(rowp + bj * HALF) = w; } }
    }
};
__device__ __forceinline__ float silu_mul(float g, float u) { return g * __builtin_amdgcn_rcpf(1.0f + __builtin_amdgcn_exp2f(-1.4426950408889634f * g)) * u; }
struct EpiSwiGLU {
    static constexpr bool PERM = true;
    bf16_t* O; int ldc;
    __device__ __forceinline__ void operator()(const f32x4 (&acc)[2][2][4][2], const Unit& u, int wr, int wc, int fr, int fq) const {
        const int row0 = u.pm * BM + wr * 64 + fr; const int col0 = u.pn * HALF + wc * 32 + 8 * fq;
#pragma unroll
        for (int ai = 0; ai < 2; ++ai)
#pragma unroll
            for (int m = 0; m < 4; ++m) { bf16_t* rowp = O + (size_t)(row0 + ai * HALF + m * 16) * ldc + col0;
                const f32x4 g0 = acc[ai][0][m][0], g1 = acc[ai][0][m][1], u0 = acc[ai][1][m][0], u1 = acc[ai][1][m][1];
                const f32x4 a0 = g0 * -1.4426950408889634f, a1 = g1 * -1.4426950408889634f;
                f32x4 e0, e1;
                e0[0] = __builtin_amdgcn_exp2f(a0[0]); e0[1] = __builtin_amdgcn_exp2f(a0[1]); e0[2] = __builtin_amdgcn_exp2f(a0[2]); e0[3] = __builtin_amdgcn_exp2f(a0[3]);
                e1[0] = __builtin_amdgcn_exp2f(a1[0]); e1[1] = __builtin_amdgcn_exp2f(a1[1]); e1[2] = __builtin_amdgcn_exp2f(a1[2]); e1[3] = __builtin_amdgcn_exp2f(a1[3]);
                const f32x4 d0 = e0 + 1.0f, d1 = e1 + 1.0f; const f32x4 t0 = g0 * u0, t1 = g1 * u1;
                f32x4 r0, r1;
                r0[0] = __builtin_amdgcn_rcpf(d0[0]); r0[1] = __builtin_amdgcn_rcpf(d0[1]); r0[2] = __builtin_amdgcn_rcpf(d0[2]); r0[3] = __builtin_amdgcn_rcpf(d0[3]);
                r1[0] = __builtin_amdgcn_rcpf(d1[0]); r1[1] = __builtin_amdgcn_rcpf(d1[1]); r1[2] = __builtin_amdgcn_rcpf(d1[2]); r1[3] = __builtin_amdgcn_rcpf(d1[3]);
                const f32x4 h0 = t0 * r0, h1 = t1 * r1;
                u32x4 w; w.x = cvt_pk_s(h0[0], h0[1]); w.y = cvt_pk_s(h0[2], h0[3]); w.z = cvt_pk_s(h1[0], h1[1]); w.w = cvt_pk_s(h1[2], h1[3]);
                *(u32x4*)rowp = w; }
    }
};

template <class Epi>
__device__ __forceinline__ void gemm_phase(LAS unsigned char* lds, const Gemm g, const StaticOrder& S, const Epi& E) {
    const int tid = opaque_tid(), wid = __builtin_amdgcn_readfirstlane(tid >> 6), lane = tid & 63, wr = wid >> 2, wc = wid & 3, fr = lane & 15, fq = lane >> 4;
    const int K = g.K, nt = K / BK;
    unsigned voffA[2], voffB[2];
#pragma unroll
    for (int i = 0; i < 2; ++i) { int R, C; stage_rc(tid * 16 + i * 8192, R, C); const int Rb = Epi::PERM ? ((R & ~31) + perm32(R & 31)) : R;
        voffA[i] = (unsigned)(R * g.lda + C) * 2u; voffB[i] = (unsigned)(Rb * g.ldb + C) * 2u; }
    const size_t kstep = (size_t)(BK * 2);
    const size_t hstepA = (size_t)HALF * g.lda * 2, hstepB = (size_t)HALF * g.ldb * 2;
    const size_t tstepA = 2 * hstepA, tstepB = 2 * hstepB;
    const unsigned ldsw = (unsigned)wid * 1024u;
    const int aoff = lds_byte(wr * 64 + fr, fq * 8), boff = lds_byte(wc * 32 + fr, fq * 8);
#define PG8_SA(b, h) (((b) * 2 + (h)) * HTB)
#define PG8_SB(b, h) ((4 + (b) * 2 + (h)) * HTB)
#define PG8_STAGE(bufoff, gbase, voff) do { _Pragma("unroll") for (int _i = 0; _i < 2; ++_i) \
        __builtin_amdgcn_global_load_lds((const unsigned*)((const char*)(gbase) + (voff)[_i]), (LAS unsigned*)(lds + (bufoff) + ldsw + _i * 8192), 16, 0, 0); } while (0)
#define PG8_LDA(dst, b, h) do { _Pragma("unroll") for (int m = 0; m < 4; ++m) _Pragma("unroll") for (int k = 0; k < 2; ++k) dst[m][k] = *(const LAS bf16x8*)(lds + PG8_SA(b, h) + aoff + m * 2048 + k * 1024); } while (0)
#define PG8_LDB(dst, b, h) do { _Pragma("unroll") for (int n = 0; n < 2; ++n) _Pragma("unroll") for (int k = 0; k < 2; ++k) dst[n][k] = *(const LAS bf16x8*)(lds + PG8_SB(b, h) + boff + n * 2048 + k * 1024); } while (0)
#define PG8_MMA(ai, bj, At, Bt) do { __builtin_amdgcn_s_setprio(1); _Pragma("unroll") for (int m = 0; m < 4; ++m) _Pragma("unroll") for (int n = 0; n < 2; ++n) _Pragma("unroll") for (int k = 0; k < 2; ++k) \
        acc[ai][bj][m][n] = __builtin_amdgcn_mfma_f32_16x16x32_bf16(Bt[n][k], At[m][k], acc[ai][bj][m][n], 0, 0, 0); __builtin_amdgcn_s_setprio(0); } while (0)
#define PG8_WAIT_V(n) asm volatile("s_waitcnt vmcnt(" #n ")" ::: "memory")
#define PG8_WAIT_L(n) asm volatile("s_waitcnt lgkmcnt(" #n ")" ::: "memory")
#define PG8_BAR __builtin_amdgcn_s_barrier()
#define PG8_SCHED __builtin_amdgcn_sched_barrier(0)
#define PG8_AOFF(u) ((size_t)(u).pm * tstepA + (g.agrp ? (size_t)((u).pn / g.agrp) * (size_t)K * 2 : (size_t)0))
    Unit cur, nxt; int ui = 0;
    if (!S.next(0, cur)) return;
    f32x4 acc[2][2][4][2];
#pragma unroll
    for (int a = 0; a < 2; ++a)
#pragma unroll
        for (int b = 0; b < 2; ++b)
#pragma unroll
            for (int m = 0; m < 4; ++m)
#pragma unroll
                for (int n = 0; n < 2; ++n) acc[a][b][m][n] = (f32x4){0.f, 0.f, 0.f, 0.f};
    bf16x8 At[4][2], B0[2][2], B1[2][2];
    const char* cA = (const char*)g.A + PG8_AOFF(cur); const char* cB = (const char*)g.Bt + (size_t)cur.pn * tstepB;
    PG8_STAGE(PG8_SB(0, 0), cB, voffB); PG8_STAGE(PG8_SB(0, 1), cB + hstepB, voffB); PG8_STAGE(PG8_SA(0, 0), cA, voffA); PG8_STAGE(PG8_SA(0, 1), cA + hstepA, voffA);
    if (wr == 1) PG8_BAR;
    PG8_WAIT_V(2); PG8_BAR;
    PG8_STAGE(PG8_SB(1, 0), cB + kstep, voffB); PG8_STAGE(PG8_SA(1, 0), cA + kstep, voffA); PG8_STAGE(PG8_SB(1, 1), cB + hstepB + kstep, voffB);
    PG8_WAIT_V(6); PG8_BAR;
    for (;;) {
        const bool has_next = S.next(ui + 1, nxt);
        const char* nA = has_next ? (const char*)g.A + PG8_AOFF(nxt) : cA; const char* nB = has_next ? (const char*)g.Bt + (size_t)nxt.pn * tstepB : cB;
        for (int t = 0; t < nt; t += 2) {
            const bool last = (t == nt - 2);
            const char* a1 = cA + (size_t)(t + 1) * kstep;
            const char* a2 = last ? nA : cA + (size_t)(t + 2) * kstep; const char* b2 = last ? nB : cB + (size_t)(t + 2) * kstep;
            const char* a3 = a2 + kstep; const char* b3 = b2 + kstep;
            PG8_LDB(B0, 0, 0); PG8_LDB(B1, 0, 1); PG8_SCHED; PG8_LDA(At, 0, 0); PG8_STAGE(PG8_SA(1, 1), a1 + hstepA, voffA);
            PG8_WAIT_V(8); PG8_WAIT_L(0); PG8_BAR; PG8_MMA(0, 0, At, B0); PG8_MMA(0, 1, At, B1); PG8_BAR; PG8_SCHED;
            PG8_LDA(At, 0, 1); PG8_STAGE(PG8_SB(0, 0), b2, voffB); PG8_STAGE(PG8_SB(0, 1), b2 + hstepB, voffB); PG8_STAGE(PG8_SA(0, 0), a2, voffA);
            PG8_WAIT_V(8); PG8_WAIT_L(0); PG8_BAR; PG8_MMA(1, 0, At, B0); PG8_MMA(1, 1, At, B1); PG8_BAR; PG8_SCHED;
            PG8_LDB(B0, 1, 0); PG8_LDB(B1, 1, 1); PG8_SCHED; PG8_LDA(At, 1, 0); PG8_STAGE(PG8_SA(0, 1), a2 + hstepA, voffA);
            PG8_WAIT_V(8); PG8_WAIT_L(0); PG8_BAR; PG8_MMA(0, 0, At, B0); PG8_MMA(0, 1, At, B1); PG8_BAR; PG8_SCHED;
            PG8_LDA(At, 1, 1); PG8_STAGE(PG8_SB(1, 0), b3, voffB); PG8_STAGE(PG8_SB(1, 1), b3 + hstepB, voffB); PG8_STAGE(PG8_SA(1, 0), a3, voffA);
            PG8_WAIT_V(8); PG8_WAIT_L(0); PG8_BAR; PG8_MMA(1, 0, At, B0); PG8_MMA(1, 1, At, B1); PG8_BAR; PG8_SCHED;
        }
        if (wr == 0) PG8_BAR;
        E(acc, cur, wr, wc, fr, fq);
        if (!has_next) break;
#pragma unroll
        for (int a = 0; a < 2; ++a)
#pragma unroll
            for (int b = 0; b < 2; ++b)
#pragma unroll
                for (int m = 0; m < 4; ++m)
#pragma unroll
                    for (int n = 0; n < 2; ++n) acc[a][b][m][n] = (f32x4){0.f, 0.f, 0.f, 0.f};
        cur = nxt; cA = nA; cB = nB; ++ui;
        if (wr == 1) PG8_BAR;
    }
    PG8_WAIT_V(0);
    PG8_BAR;
#undef PG8_SA
#undef PG8_SB
#undef PG8_STAGE
#undef PG8_LDA
#undef PG8_LDB
#undef PG8_MMA
#undef PG8_WAIT_V
#undef PG8_WAIT_L
#undef PG8_BAR
#undef PG8_SCHED
#undef PG8_AOFF
}
}

namespace att {
constexpr int NW = 8, QBLK = 32, KVBLK = 64;
constexpr int SHM_V = 16384, SHM_K = 16384, SHM_KR = 8192;
constexpr int NSLOT = 3;
constexpr int OFF_V = 0, OFF_K = NSLOT * SHM_V, OFF_KR = OFF_K + NSLOT * SHM_K, OFF_WS = OFF_KR + NSLOT * SHM_KR, OFF_QR = OFF_WS + NW * 64 * 4, LDS_BYTES = OFF_QR + NW * 4096;
constexpr float THR = 8.f;
#define KSWZ(row, colB) ((row) * 256 + ((colB) ^ (((row) & 7) << 4)))
#define KRSWZ(row, chunk) ((row) * 128 + ((((chunk) ^ (((row) >> 1) & 7))) << 4))
#define SBAR() __builtin_amdgcn_sched_barrier(0)
__device__ __forceinline__ int crow(int r, int hi) { return (r & 3) + 8 * (r >> 2) + 4 * hi; }

constexpr float THR2 = 8.f * 1.4426950408889634f;
__device__ __forceinline__ float max3f(float a, float b, float c) { return __builtin_fmaxf(__builtin_fmaxf(a, b), c); }
template <bool FIRST, bool MLA>
__device__ __forceinline__ void partialSM(f32x16& p0, f32x16& p1, f32x16& negm, float& m_reg, float& alpha) {
  float a = max3f(p0[0], p0[1], p1[0]), b = max3f(p0[2], p0[3], p1[1]); a = max3f(a, p1[2], p1[3]);
#pragma unroll
  for (int r = 4; r < 16; r += 4) { a = max3f(a, p0[r], p0[r + 1]); b = max3f(b, p0[r + 2], p0[r + 3]); a = max3f(a, p1[r], p1[r + 1]); b = max3f(b, p1[r + 2], p1[r + 3]); }
  float pmax = fmaxf(a, b);
  { auto rr = __builtin_amdgcn_permlane32_swap(__float_as_uint(pmax), __float_as_uint(pmax), false, false);
    pmax = fmaxf(__uint_as_float(rr[0]), __uint_as_float(rr[1])); }
  alpha = 1.f;
  if constexpr (MLA) {
    if (FIRST) m_reg = pmax;
    else if (!__builtin_expect(__all(pmax - m_reg <= THR2), 1)) { const float mn = fmaxf(m_reg, pmax); alpha = __builtin_amdgcn_exp2f(m_reg - mn); m_reg = mn; }
#pragma unroll
    for (int r = 0; r < 16; ++r) { p0[r] -= m_reg; p1[r] -= m_reg; }
  } else
  if (FIRST || __builtin_expect(__any(pmax > THR2), 0)) {
    const float d = FIRST ? pmax : fmaxf(pmax, 0.f);
#pragma unroll
    for (int r = 0; r < 16; ++r) { p0[r] -= d; p1[r] -= d; }
#pragma unroll
    for (int r = 0; r < 16; ++r) negm[r] -= d;
    asm volatile("" : "+v"(negm));
    if (!FIRST) alpha = __builtin_amdgcn_exp2f(-d);
  }
#pragma unroll
  for (int r = 0; r < 16; ++r) p0[r] = __builtin_amdgcn_exp2f(p0[r]);
}
__device__ __forceinline__ void finishSM(f32x16& p0, f32x16& p1, float alpha, float& l_reg, bf16x8& pa0, bf16x8& pa1, bf16x8& pa2, bf16x8& pa3) {
#pragma unroll
  for (int r = 0; r < 16; ++r) p1[r] = __builtin_amdgcn_exp2f(p1[r]);
  float ps = 0;
#pragma unroll
  for (int r = 0; r < 16; ++r) ps += p0[r];
#pragma unroll
  for (int r = 0; r < 16; ++r) ps += p1[r];
  { auto rr = __builtin_amdgcn_permlane32_swap(__float_as_uint(ps), __float_as_uint(ps), false, false);
    ps = __uint_as_float(rr[0]) + __uint_as_float(rr[1]); }
  l_reg = l_reg * alpha + ps;
#define PK4(P, BASE, OUT) do { unsigned a0 = cvt_pk_bf16(P[BASE + 0], P[BASE + 1]), a1 = cvt_pk_bf16(P[BASE + 2], P[BASE + 3]);   \
    unsigned b0 = cvt_pk_bf16(P[BASE + 4], P[BASE + 5]), b1 = cvt_pk_bf16(P[BASE + 6], P[BASE + 7]);                              \
    auto r0 = __builtin_amdgcn_permlane32_swap(a0, b0, false, false); auto r1 = __builtin_amdgcn_permlane32_swap(a1, b1, false, false); \
    u32x4 w = {r0[0], r1[0], r0[1], r1[1]}; OUT = *reinterpret_cast<bf16x8*>(&w); } while (0)
  PK4(p0, 0, pa0); PK4(p0, 8, pa1); PK4(p1, 0, pa2); PK4(p1, 8, pa3);
#undef PK4
}
template <bool MLA>
__device__ __forceinline__ void qkt(f32x16& p0, f32x16& p1, const char* Ks, const char* KRs, const bf16x8* qr, const char* qrl, const f32x16& negm, int r32, int hi) {
#pragma unroll
  for (int d0 = 0; d0 < 8; ++d0) { int cb = (d0 * 16 + hi * 8) * 2;
    bf16x8 b0 = *reinterpret_cast<const bf16x8*>(Ks + KSWZ(r32, cb));
    bf16x8 b1 = *reinterpret_cast<const bf16x8*>(Ks + KSWZ(32 + r32, cb));
    if (d0 == 0) { p0 = __builtin_amdgcn_mfma_f32_32x32x16_bf16(b0, qr[0], negm, 0, 0, 0); p1 = __builtin_amdgcn_mfma_f32_32x32x16_bf16(b1, qr[0], negm, 0, 0, 0); }
    else { p0 = __builtin_amdgcn_mfma_f32_32x32x16_bf16(b0, qr[d0], p0, 0, 0, 0); p1 = __builtin_amdgcn_mfma_f32_32x32x16_bf16(b1, qr[d0], p1, 0, 0, 0); } }
  if constexpr (MLA) {
#pragma unroll
    for (int d0 = 0; d0 < 4; ++d0) { int ch = d0 * 2 + hi;
      bf16x8 b0 = *reinterpret_cast<const bf16x8*>(KRs + KRSWZ(r32, ch));
      bf16x8 b1 = *reinterpret_cast<const bf16x8*>(KRs + KRSWZ(32 + r32, ch));
      const bf16x8 qq = *reinterpret_cast<const bf16x8*>(qrl + d0 * 1024);
      p0 = __builtin_amdgcn_mfma_f32_32x32x16_bf16(b0, qq, p0, 0, 0, 0);
      p1 = __builtin_amdgcn_mfma_f32_32x32x16_bf16(b1, qq, p1, 0, 0, 0); }
  }
}
__device__ __forceinline__ int v_st(int k, int c) { const int kk = (k & ~0xC) | ((k & 4) << 1) | ((k & 8) >> 1); return ((kk >> 3) * 4 + (c >> 5)) * 512 + ((kk & 7) * 32 + (c & 31)) * 2; }
__device__ __forceinline__ int v_rd_base(int lane) { return ((lane & 3) << 3) | (((lane >> 2) & 3) << 6) | (((lane >> 4) & 1) << 5) | (((lane >> 5) & 1) << 8); }
constexpr int v_rd_off(int d0, int ks, int half) { return d0 * 512 + ks * 4096 + half * 2048; }
template <int OFF> __device__ __forceinline__ s16x4 tr_read(int vb) {
  s16x4 r; asm volatile("ds_read_b64_tr_b16 %0, %1 offset:%2" : "=&v"(r) : "v"(vb), "i"(OFF) : "memory"); return r;
}
template <int D0> __device__ __forceinline__ void pv_one(f32x16& od, int vb, bf16x8 pa0, bf16x8 pa1, bf16x8 pa2, bf16x8 pa3) {
  const s16x4 l0 = tr_read<v_rd_off(D0, 0, 0)>(vb), h0 = tr_read<v_rd_off(D0, 0, 1)>(vb), l1 = tr_read<v_rd_off(D0, 1, 0)>(vb), h1 = tr_read<v_rd_off(D0, 1, 1)>(vb);
  const s16x4 l2 = tr_read<v_rd_off(D0, 2, 0)>(vb), h2 = tr_read<v_rd_off(D0, 2, 1)>(vb), l3 = tr_read<v_rd_off(D0, 3, 0)>(vb), h3 = tr_read<v_rd_off(D0, 3, 1)>(vb);
  asm volatile("s_waitcnt lgkmcnt(0)" ::: "memory"); SBAR();
#define PK(L, H) (bf16x8){L[0], L[1], L[2], L[3], H[0], H[1], H[2], H[3]}
  od = __builtin_amdgcn_mfma_f32_32x32x16_bf16(pa0, PK(l0, h0), od, 0, 0, 0);
  od = __builtin_amdgcn_mfma_f32_32x32x16_bf16(pa1, PK(l1, h1), od, 0, 0, 0);
  od = __builtin_amdgcn_mfma_f32_32x32x16_bf16(pa2, PK(l2, h2), od, 0, 0, 0);
  od = __builtin_amdgcn_mfma_f32_32x32x16_bf16(pa3, PK(l3, h3), od, 0, 0, 0);
#undef PK
}
__device__ __forceinline__ void pv_d0(f32x16* o, int vb, bf16x8 pa0, bf16x8 pa1, bf16x8 pa2, bf16x8 pa3) {
  pv_one<0>(o[0], vb, pa0, pa1, pa2, pa3); pv_one<1>(o[1], vb, pa0, pa1, pa2, pa3); pv_one<2>(o[2], vb, pa0, pa1, pa2, pa3); pv_one<3>(o[3], vb, pa0, pa1, pa2, pa3);
}

template <bool MLA>
__device__ __forceinline__ void attn_unit(const bf16_t* __restrict__ Qb, const bf16_t* __restrict__ Qrb, const bf16_t* __restrict__ Kh, const bf16_t* __restrict__ Krh,
                                          const bf16_t* __restrict__ Vh, bf16_t* Ob, char* lds, LAS unsigned char* ldsl) {
  constexpr int LDQ = LDQQ, LDO = LDQQ, LDK = MLA ? 2048 : LDQQ, LDKR = LDPB, NT = SEQ / KVBLK;
  const int tid = opaque_tid(), wid = __builtin_amdgcn_readfirstlane(tid >> 6), lane = tid & 63, r32 = lane & 31, hi = lane >> 5;
  char* V_lds = lds + OFF_V; char* K_lds = lds + OFF_K; char* KR_lds = lds + OFF_KR;
  float* ws = (float*)(lds + OFF_WS) + wid * 64; float* li_l = ws; float* al_l = ws + 32;
  unsigned koff[2], voff[2], kroff = 0;
#pragma unroll
  for (int i = 0; i < 2; ++i) { const int p = 2 * wid + i;
    { const int row = 4 * p + (lane >> 4), pc = lane & 15, c = pc ^ (row & 7); koff[i] = (unsigned)(row * LDK + c * 8) * 2u; }
    { const int o = p * 1024 + lane * 16, sub = o >> 9, w_ = (o & 511) >> 1, kk = (sub >> 2) * 8 + (w_ >> 5), k = (kk & ~0xC) | ((kk & 4) << 1) | ((kk & 8) >> 1), c = (sub & 3) * 32 + (w_ & 31);
      voff[i] = (unsigned)(k * LDK + c) * 2u; } }
  if constexpr (MLA) { const int row = 8 * wid + (lane >> 3), pc = lane & 7, ch = pc ^ ((row >> 1) & 7); kroff = (unsigned)(row * LDKR + ch * 8) * 2u; }
#define DMA_TILE(t, slot) do { const char* kb_ = (const char*)Kh + (size_t)(t) * (KVBLK * LDK * 2); const char* vb_ = (const char*)Vh + (size_t)(t) * (KVBLK * LDK * 2); \
    _Pragma("unroll") for (int i_ = 0; i_ < 2; ++i_) { \
      __builtin_amdgcn_global_load_lds((const unsigned*)(kb_ + koff[i_]), (LAS unsigned*)(ldsl + OFF_K + (slot) * SHM_K + (2 * wid + i_) * 1024), 16, 0, 0); \
      __builtin_amdgcn_global_load_lds((const unsigned*)(vb_ + voff[i_]), (LAS unsigned*)(ldsl + OFF_V + (slot) * SHM_V + (2 * wid + i_) * 1024), 16, 0, 0); } \
    if constexpr (MLA) __builtin_amdgcn_global_load_lds((const unsigned*)((const char*)Krh + (size_t)(t) * (KVBLK * LDKR * 2) + kroff), (LAS unsigned*)(ldsl + OFF_KR + (slot) * SHM_KR + wid * 1024), 16, 0, 0); } while (0)
#define WAIT_BAR() do { asm volatile("s_waitcnt vmcnt(0)" ::: "memory"); __syncthreads(); } while (0)
  DMA_TILE(0, 0); DMA_TILE(1, 1);
  float l_reg = 0, m_reg = 0; f32x16 o[4] = {}; bf16x8 qr[8]; f32x16 negm = {}; asm volatile("" : "+v"(negm));
  char* qrl = lds + OFF_QR + wid * 4096 + lane * 16;
  { const bf16_t* Qw = Qb + (long)(wid * QBLK + r32) * LDQ + hi * 8;
#pragma unroll
    for (int d0 = 0; d0 < 8; ++d0) qr[d0] = *reinterpret_cast<const bf16x8*>(Qw + d0 * 16);
    if constexpr (MLA) { const bf16_t* Qw2 = Qrb + (long)(wid * QBLK + r32) * LDQ + hi * 8;
#pragma unroll
      for (int d0 = 0; d0 < 4; ++d0) *reinterpret_cast<bf16x8*>(qrl + d0 * 1024) = *reinterpret_cast<const bf16x8*>(Qw2 + d0 * 16); } }
  const int vb0 = (int)(uintptr_t)V_lds + v_rd_base(lane);
#define RESC(a) do { if (__any((a) < 1.f)) { if (hi == 0) al_l[r32] = (a); asm volatile("s_waitcnt lgkmcnt(0)" ::: "memory"); \
    _Pragma("unroll") for (int d = 0; d < 4; ++d) _Pragma("unroll") for (int r = 0; r < 16; ++r) o[d][r] *= al_l[crow(r, hi)]; } } while (0)
  f32x16 pA0, pA1, pB0, pB1; float alA, alB; bf16x8 pa0, pa1, pa2, pa3;
  WAIT_BAR();
  qkt<MLA>(pA0, pA1, K_lds, KR_lds, qr, qrl, negm, r32, hi); partialSM<true, false>(pA0, pA1, negm, m_reg, alA);
  int s_prev = 0, s_cur = 1, s_next = 2;
#define ROT() do { const int t_ = s_prev; s_prev = s_cur; s_cur = s_next; s_next = t_; } while (0)
  for (int j = 1; j + 1 < NT; j += 2) {
    SBAR(); DMA_TILE(j + 1, s_next); SBAR();
    qkt<MLA>(pB0, pB1, K_lds + s_cur * SHM_K, KR_lds + s_cur * SHM_KR, qr, qrl, negm, r32, hi);
    finishSM(pA0, pA1, alA, l_reg, pa0, pa1, pa2, pa3);
    pv_d0(o, vb0 + s_prev * SHM_V, pa0, pa1, pa2, pa3); partialSM<false, false>(pB0, pB1, negm, m_reg, alB);
    RESC(alB); WAIT_BAR(); ROT();
    SBAR(); DMA_TILE(j + 2, s_next); SBAR();
    qkt<MLA>(pA0, pA1, K_lds + s_cur * SHM_K, KR_lds + s_cur * SHM_KR, qr, qrl, negm, r32, hi);
    finishSM(pB0, pB1, alB, l_reg, pa0, pa1, pa2, pa3);
    pv_d0(o, vb0 + s_prev * SHM_V, pa0, pa1, pa2, pa3); partialSM<false, false>(pA0, pA1, negm, m_reg, alA);
    RESC(alA); WAIT_BAR(); ROT();
  }
  SBAR(); qkt<MLA>(pB0, pB1, K_lds + s_cur * SHM_K, KR_lds + s_cur * SHM_KR, qr, qrl, negm, r32, hi);
  finishSM(pA0, pA1, alA, l_reg, pa0, pa1, pa2, pa3); SBAR();
  pv_d0(o, vb0 + s_prev * SHM_V, pa0, pa1, pa2, pa3); partialSM<false, false>(pB0, pB1, negm, m_reg, alB);
  RESC(alB);
  finishSM(pB0, pB1, alB, l_reg, pa0, pa1, pa2, pa3); SBAR();
  pv_d0(o, vb0 + s_cur * SHM_V, pa0, pa1, pa2, pa3);
  if (hi == 0) li_l[r32] = l_reg; asm volatile("s_waitcnt lgkmcnt(0)" ::: "memory");
  float rli[16];
#pragma unroll
  for (int r = 0; r < 16; ++r) rli[r] = __builtin_amdgcn_rcpf(li_l[crow(r, hi)]);
  bf16_t* Ow = Ob + (long)(wid * QBLK) * LDO;
#pragma unroll
  for (int r = 0; r < 16; ++r) { int orow = crow(r, hi);
#pragma unroll
    for (int d0 = 0; d0 < 4; ++d0) Ow[(long)orow * LDO + d0 * 32 + r32] = (bf16_t)(cvt_pk_bf16(o[d0][r] * rli[r], 0.f) & 0xffffu); }
  __syncthreads();
#undef DMA_TILE
#undef WAIT_BAR
#undef RESC
#undef ROT
}
}


#define XB_TMO      128
#define XB_XCNT(j)  (256  + 64 * (j))
#define XB_XSUB(j)  (1280 + 64 * (j))
#define XB_XGEN(j)  (2304 + 64 * (j))
#define XB_TOP      3328
#define XB_TOPGEN   3392
#define XCD_BAR_WORDS 3456
#define XB_SPIN_CAP (1u << 18)
__device__ __forceinline__ unsigned xb_ld(unsigned* p)              { return __hip_atomic_load(p, __ATOMIC_RELAXED, __HIP_MEMORY_SCOPE_AGENT); }
__device__ __forceinline__ unsigned xb_add(unsigned* p, unsigned v) { return __hip_atomic_fetch_add(p, v, __ATOMIC_RELAXED, __HIP_MEMORY_SCOPE_AGENT); }
__device__ __forceinline__ unsigned xb_xcc_id() { return (unsigned)__builtin_amdgcn_s_getreg((3 << 11) | 20) & 0xFu; }
#define XB_SPIN(cond, bar) do { unsigned _sp = 0; while (cond) { __builtin_amdgcn_s_sleep(1); \
    if ((++_sp & 255u) == 0u) { if (xb_ld(&(bar)[XB_TMO])) break; if (_sp > XB_SPIN_CAP) { atomicAdd(&(bar)[XB_TMO], 1u); break; } } } } while (0)
__device__ __forceinline__ void xcd_barrier_complete(unsigned* bar, unsigned x, unsigned& nloc, unsigned& nx) {
    const unsigned G = gridDim.x * gridDim.y * gridDim.z;
    unsigned sum, cnt, mine, sp = 0u;
    for (;;) {
        sum = 0u; cnt = 0u; mine = 0u;
#pragma unroll
        for (unsigned j = 0; j < 16; ++j) { const unsigned c = xb_ld(&bar[XB_XCNT(j)]); sum += c; cnt += (c > 0u) ? 1u : 0u; mine = (j == x) ? c : mine; }
        if (sum == G) break;
        __builtin_amdgcn_s_sleep(1);
        if ((++sp & 255u) == 0u) { if (xb_ld(&bar[XB_TMO])) break; if (sp > XB_SPIN_CAP) { atomicAdd(&bar[XB_TMO], 1u); break; } }
    }
    nloc = mine > 0u ? mine : 1u; nx = cnt > 0u ? cnt : 1u;
}
__device__ __forceinline__ void xcd_barrier(unsigned* bar, volatile LAS unsigned* st) {
    asm volatile("s_waitcnt vmcnt(0)" ::: "memory");
    __syncthreads();
    if (threadIdx.x == 0) {
        const unsigned x = xb_xcc_id();
        __builtin_amdgcn_s_waitcnt(0);
        unsigned nloc = st[0], nx = st[1];
        if (nloc == 0u) { xcd_barrier_complete(bar, x, nloc, nx); st[0] = nloc; st[1] = nx; }
        const unsigned old = xb_add(&bar[XB_XSUB(x)], 1u);
        const unsigned gen = old / nloc;
        if (old + 1u == (gen + 1u) * nloc) {
            __builtin_amdgcn_fence(__ATOMIC_RELEASE, "agent");
            asm volatile("s_waitcnt vmcnt(0)" ::: "memory");
            const unsigned og = xb_add(&bar[XB_TOP], 1u);
            const unsigned tg = og / nx;
            if (og + 1u == (tg + 1u) * nx) xb_add(&bar[XB_TOPGEN], 1u);
            else XB_SPIN(xb_ld(&bar[XB_TOPGEN]) == tg, bar);
            __builtin_amdgcn_fence(__ATOMIC_ACQUIRE, "agent");
            xb_add(&bar[XB_XGEN(x)], 1u);
            asm volatile("s_waitcnt vmcnt(0)" ::: "memory");
        } else {
            XB_SPIN(xb_ld(&bar[XB_XGEN(x)]) == gen, bar);
            __builtin_amdgcn_fence(__ATOMIC_ACQUIRE, "agent");
            asm volatile("s_waitcnt vmcnt(0)" ::: "memory");
        }
    }
    __syncthreads();
}

struct Params { const float* in[36]; float* out; unsigned char* ws; long ph_lo, ph_hi; };
constexpr int LDS_BYTES = 163840;

__device__ __forceinline__ int transpose_dst(int mode, int n0) {
    if (mode == 1) return (n0 >> 7) * 256 + (n0 & 127);
    if (mode == 2) return (n0 >> 7) * 256 + 128 + (n0 & 127);
    if (mode == 3) { const int h = n0 / 192, d0 = n0 % 192; return d0 < 128 ? h * 128 + d0 : 1024 + h * 64 + (d0 - 128); }
    return n0;
}
__device__ __forceinline__ void transpose_matrix(const float* W, int K, int N, bf16_t* WT, int ldt, int mode, int gw, int NGW, int lane, float wscale = 1.0f, const float* nscale = nullptr) {
    constexpr int NI = 4;
    const int nblk = N / 32, nitems = (K / 64) * nblk; const int kg = lane >> 3, nq = lane & 7;
    for (int it0 = gw; it0 < nitems; it0 += NGW * NI) {
        f32x4 v[NI][8];
#pragma unroll
        for (int q = 0; q < NI; ++q) { const int it = it0 + q * NGW; if (it < nitems) { const int kb = it / nblk, nb = it % nblk;
#pragma unroll
            for (int i = 0; i < 8; ++i) v[q][i] = *(const f32x4*)(W + (size_t)(64 * kb + 8 * kg + i) * N + 32 * nb + 4 * nq); } }
#pragma unroll
        for (int q = 0; q < NI; ++q) { const int it = it0 + q * NGW; if (it < nitems) { const int kb = it / nblk, nb = it % nblk, dst = transpose_dst(mode, 32 * nb);
            f32x4 ns = {wscale, wscale, wscale, wscale}; if (nscale) ns = *(const f32x4*)(nscale + 32 * nb + 4 * nq) * wscale;
#pragma unroll
            for (int c = 0; c < 4; ++c) { const float ws_ = ns[c]; u32x4 o; o.x = cvt_pk_bf16(v[q][0][c] * ws_, v[q][1][c] * ws_); o.y = cvt_pk_bf16(v[q][2][c] * ws_, v[q][3][c] * ws_); o.z = cvt_pk_bf16(v[q][4][c] * ws_, v[q][5][c] * ws_); o.w = cvt_pk_bf16(v[q][6][c] * ws_, v[q][7][c] * ws_);
                *(u32x4*)(WT + (size_t)(dst + 4 * nq + c) * ldt + 64 * kb + 8 * kg) = o; } } }
    }
}
__device__ __forceinline__ const float* xin_row(const Params& p, int r) { return r < NPROMPT ? p.in[0] + (size_t)r * DM : p.in[1] + (size_t)(r - NPROMPT) * DM; }

__device__ __forceinline__ void prenorm_rows(const Params& p, const float* g, bf16_t* XN, int gw, int NGW, int lane) {
    f32x4 gg[8];
#pragma unroll
    for (int j = 0; j < 4; ++j) { gg[2 * j] = *(const f32x4*)(g + j * 512 + lane * 8); gg[2 * j + 1] = *(const f32x4*)(g + j * 512 + lane * 8 + 4); }
    for (int r0 = gw; r0 < T; r0 += 2 * NGW) {
        int rr[2]; rr[0] = r0; rr[1] = (r0 + NGW < T) ? r0 + NGW : r0;
        f32x4 v[2][8];
#pragma unroll
        for (int k = 0; k < 2; ++k) { const float* xr = xin_row(p, rr[k]);
#pragma unroll
            for (int j = 0; j < 4; ++j) { v[k][2 * j] = *(const f32x4*)(xr + j * 512 + lane * 8); v[k][2 * j + 1] = *(const f32x4*)(xr + j * 512 + lane * 8 + 4); } }
#pragma unroll
        for (int k = 0; k < 2; ++k) { float ss = 0.f;
#pragma unroll
            for (int j = 0; j < 8; ++j) ss += (v[k][j].x * v[k][j].x + v[k][j].y * v[k][j].y) + (v[k][j].z * v[k][j].z + v[k][j].w * v[k][j].w);
            const float rstd = rsqrtf(wave_sum(ss) * (1.f / DM) + EPS);
#pragma unroll
            for (int j = 0; j < 4; ++j) { const f32x4 a = v[k][2 * j] * rstd * gg[2 * j], b = v[k][2 * j + 1] * rstd * gg[2 * j + 1];
                u32x4 w; w.x = cvt_pk_bf16(a.x, a.y); w.y = cvt_pk_bf16(a.z, a.w); w.z = cvt_pk_bf16(b.x, b.y); w.w = cvt_pk_bf16(b.z, b.w);
                *(u32x4*)(XN + (size_t)rr[k] * DM + j * 512 + lane * 8) = w; } }
    }
}
__device__ __forceinline__ f32x4 ylo(const u32x4 w) { return (f32x4){bflo(w.x), bfhi(w.x), bflo(w.y), bfhi(w.y)}; }
__device__ __forceinline__ f32x4 yhi(const u32x4 w) { return (f32x4){bflo(w.z), bfhi(w.z), bflo(w.w), bfhi(w.w)}; }
__device__ __forceinline__ float sq4(const f32x4 t) { return (t.x * t.x + t.y * t.y) + (t.z * t.z + t.w * t.w); }
__device__ __forceinline__ void resid_rows(const Params& p, const bf16_t* Y, const float* cs, const float* post_g, float alpha, bool first, const float* next_g, bf16_t* XN, bf16_t* X16,
                                           int gw, int NGW, int lane) {
    const bool last = (next_g == nullptr);
    f32x4 pg[8], ng[8];
#pragma unroll
    for (int j = 0; j < 4; ++j) { pg[2 * j] = *(const f32x4*)(post_g + j * 512 + lane * 8); pg[2 * j + 1] = *(const f32x4*)(post_g + j * 512 + lane * 8 + 4); }
    if (cs) {
#pragma unroll
        for (int j = 0; j < 4; ++j) { pg[2 * j] *= *(const f32x4*)(cs + j * 512 + lane * 8); pg[2 * j + 1] *= *(const f32x4*)(cs + j * 512 + lane * 8 + 4); }
    }
    if (next_g) {
#pragma unroll
        for (int j = 0; j < 4; ++j) { ng[2 * j] = *(const f32x4*)(next_g + j * 512 + lane * 8); ng[2 * j + 1] = *(const f32x4*)(next_g + j * 512 + lane * 8 + 4); }
    }
    for (int r = gw; r < T; r += NGW) {
        u32x4 yw[4]; f32x4 xv[8];
#pragma unroll
        for (int j = 0; j < 4; ++j) yw[j] = *(const u32x4*)(Y + (size_t)r * DM + j * 512 + lane * 8);
        if (first) { const float* xr = xin_row(p, r);
#pragma unroll
            for (int j = 0; j < 4; ++j) { xv[2 * j] = *(const f32x4*)(xr + j * 512 + lane * 8); xv[2 * j + 1] = *(const f32x4*)(xr + j * 512 + lane * 8 + 4); }
        } else { u32x4 xw[4];
#pragma unroll
            for (int j = 0; j < 4; ++j) xw[j] = *(const u32x4*)(X16 + (size_t)r * DM + j * 512 + lane * 8);
#pragma unroll
            for (int j = 0; j < 4; ++j) { xv[2 * j] = ylo(xw[j]); xv[2 * j + 1] = yhi(xw[j]); }
        }
        float ss = 0.f;
        if (cs) {
#pragma unroll
            for (int j = 0; j < 4; ++j) ss += sq4(ylo(yw[j]) * *(const f32x4*)(cs + j * 512 + lane * 8)) + sq4(yhi(yw[j]) * *(const f32x4*)(cs + j * 512 + lane * 8 + 4));
        } else {
#pragma unroll
            for (int j = 0; j < 4; ++j) ss += sq4(ylo(yw[j])) + sq4(yhi(yw[j]));
        }
        const float rs = alpha * rsqrtf(wave_sum(ss) * (1.f / DM) + EPS); float ss2 = 0.f;
#pragma unroll
        for (int j = 0; j < 4; ++j) { xv[2 * j] += (ylo(yw[j]) * rs) * pg[2 * j]; xv[2 * j + 1] += (yhi(yw[j]) * rs) * pg[2 * j + 1]; ss2 += sq4(xv[2 * j]) + sq4(xv[2 * j + 1]); }
        if (last) { float* xo = p.out + (size_t)r * DM;
#pragma unroll
            for (int j = 0; j < 4; ++j) { *(f32x4*)(xo + j * 512 + lane * 8) = xv[2 * j]; *(f32x4*)(xo + j * 512 + lane * 8 + 4) = xv[2 * j + 1]; }
        } else {
#pragma unroll
            for (int j = 0; j < 4; ++j) { const f32x4 a = xv[2 * j], b = xv[2 * j + 1];
                u32x4 w; w.x = cvt_pk_bf16(a.x, a.y); w.y = cvt_pk_bf16(a.z, a.w); w.z = cvt_pk_bf16(b.x, b.y); w.w = cvt_pk_bf16(b.z, b.w);
                *(u32x4*)(X16 + (size_t)r * DM + j * 512 + lane * 8) = w; }
            const float r2 = rsqrtf(wave_sum(ss2) * (1.f / DM) + EPS);
#pragma unroll
            for (int j = 0; j < 4; ++j) { const f32x4 a = (xv[2 * j] * r2) * ng[2 * j], b = (xv[2 * j + 1] * r2) * ng[2 * j + 1];
                u32x4 w; w.x = cvt_pk_bf16(a.x, a.y); w.y = cvt_pk_bf16(a.z, a.w); w.z = cvt_pk_bf16(b.x, b.y); w.w = cvt_pk_bf16(b.z, b.w);
                *(u32x4*)(XN + (size_t)r * DM + j * 512 + lane * 8) = w; }
        }
    }
}
__device__ __forceinline__ void unpack8(const u32x4 w, float (&x)[8]) { x[0] = bflo(w.x); x[1] = bfhi(w.x); x[2] = bflo(w.y); x[3] = bfhi(w.y); x[4] = bflo(w.z); x[5] = bfhi(w.z); x[6] = bflo(w.w); x[7] = bfhi(w.w); }
__device__ __forceinline__ float sumsq8(const float (&x)[8]) { return ((x[0] * x[0] + x[1] * x[1]) + (x[2] * x[2] + x[3] * x[3])) + ((x[4] * x[4] + x[5] * x[5]) + (x[6] * x[6] + x[7] * x[7])); }
__device__ __forceinline__ float sum16(float v) { v += __shfl_xor(v, 1); v += __shfl_xor(v, 2); v += __shfl_xor(v, 4); v += __shfl_xor(v, 8); return v; }
__device__ __forceinline__ u32x4 norm_rope8(const float (&x)[8], float rs, const float (&g)[8], const float (&c)[4], const float (&sn)[4], float qs) {
    unsigned o[4];
#pragma unroll
    for (int k = 0; k < 4; ++k) { const float a = x[2 * k] * rs * g[2 * k], b = x[2 * k + 1] * rs * g[2 * k + 1]; o[k] = cvt_pk_bf16((a * c[k] - b * sn[k]) * qs, (a * sn[k] + b * c[k]) * qs); }
    return (u32x4){o[0], o[1], o[2], o[3]};
}
__device__ __forceinline__ void qknorm_rows(const Params& p, bf16_t* QQ, bf16_t* PB, int gw, int NGW, int lane) {
    const int c = lane & 15;
    float gq[8], gk[8], gcq[8], gckv[8], fa[4], fb[4];
#pragma unroll
    for (int i = 0; i < 8; ++i) { gq[i] = p.in[9][8 * c + i]; gk[i] = p.in[10][8 * c + i]; gcq[i] = p.in[11][8 * lane + i]; gckv[i] = p.in[13][8 * (lane & 31) + i]; }
#pragma unroll
    for (int k = 0; k < 4; ++k) { fa[k] = __builtin_amdgcn_exp2f(-(float)(4 * (c & 7) + k) * (13.287712379549449f / 32.f)); fb[k] = __builtin_amdgcn_exp2f(-(float)(4 * (lane & 3) + k) * (13.287712379549449f / 16.f)); }
    for (int r = gw; r < T; r += NGW) {
        const int s = r & (SEQ - 1), ri = s >> 6, ci = s & 63;
        bf16_t* q = QQ + (size_t)r * LDQQ; bf16_t* pb = PB + (size_t)r * LDPB;
        const u32x4 z4 = {0u, 0u, 0u, 0u};
        const u32x4 wqa = *(const u32x4*)(q + lane * 8), wqb = *(const u32x4*)(q + 512 + lane * 8);
        const u32x4 wk = lane < 32 ? *(const u32x4*)(q + 2560 + lane * 8) : z4;
        const u32x4 wcq = *(const u32x4*)(pb + lane * 8);
        const u32x4 wckv = lane < 32 ? *(const u32x4*)(pb + 512 + lane * 8) : z4;
        const u32x4 wkr = lane < 8 ? *(const u32x4*)(pb + 768 + lane * 8) : z4;
        float cA[4], sA[4], cB[4], sB[4];
        { const float posA = (float)(c < 8 ? ri : ci), posB = (float)((lane & 7) < 4 ? ri : ci);
#pragma unroll
          for (int k = 0; k < 4; ++k) { rope_cs(posA * fa[k], cA[k], sA[k]); rope_cs(posB * fb[k], cB[k], sB[k]); } }
        float xa[8], xb[8], xk[8], xc[8], xv[8], xr[8];
        unpack8(wqa, xa); unpack8(wqb, xb); unpack8(wk, xk); unpack8(wcq, xc); unpack8(wckv, xv); unpack8(wkr, xr);
        const float rsa = rsqrtf(sum16(sumsq8(xa)) * (1.f / 128.f) + EPS), rsb = rsqrtf(sum16(sumsq8(xb)) * (1.f / 128.f) + EPS), rsk = rsqrtf(sum16(sumsq8(xk)) * (1.f / 128.f) + EPS);
        const float rsc = rsqrtf(wave_sum(sumsq8(xc)) * (1.f / 512.f) + EPS), rsv = rsqrtf(wave_sum(sumsq8(xv)) * (1.f / 256.f) + EPS);
        const u32x4 oqa = norm_rope8(xa, rsa, gq, cA, sA, 0.12751743f), oqb = norm_rope8(xb, rsb, gq, cA, sA, 0.12751743f);
        const u32x4 ok = norm_rope8(xk, rsk, gk, cA, sA, 1.0f);
        u32x4 ocq, ockv, okr;
        ocq.x = cvt_pk_bf16(xc[0] * rsc * gcq[0], xc[1] * rsc * gcq[1]); ocq.y = cvt_pk_bf16(xc[2] * rsc * gcq[2], xc[3] * rsc * gcq[3]);
        ocq.z = cvt_pk_bf16(xc[4] * rsc * gcq[4], xc[5] * rsc * gcq[5]); ocq.w = cvt_pk_bf16(xc[6] * rsc * gcq[6], xc[7] * rsc * gcq[7]);
        ockv.x = cvt_pk_bf16(xv[0] * rsv * gckv[0], xv[1] * rsv * gckv[1]); ockv.y = cvt_pk_bf16(xv[2] * rsv * gckv[2], xv[3] * rsv * gckv[3]);
        ockv.z = cvt_pk_bf16(xv[4] * rsv * gckv[4], xv[5] * rsv * gckv[5]); ockv.w = cvt_pk_bf16(xv[6] * rsv * gckv[6], xv[7] * rsv * gckv[7]);
        { unsigned o[4];
#pragma unroll
          for (int k = 0; k < 4; ++k) { const float a = xr[2 * k], b = xr[2 * k + 1]; o[k] = cvt_pk_bf16(a * cB[k] - b * sB[k], a * sB[k] + b * cB[k]); }
          okr = (u32x4){o[0], o[1], o[2], o[3]}; }
        *(u32x4*)(q + lane * 8) = oqa; *(u32x4*)(q + 512 + lane * 8) = oqb;
        if (lane < 32) { *(u32x4*)(q + 2560 + lane * 8) = ok; *(u32x4*)(pb + 512 + lane * 8) = ockv; }
        *(u32x4*)(pb + lane * 8) = ocq;
        if (lane < 8) *(u32x4*)(pb + 768 + lane * 8) = okr;
    }
}
__device__ __forceinline__ void qrope_rows(bf16_t* QQ, int gw, int NGW, int lane) {
    const float fB = __builtin_amdgcn_exp2f(-(float)(lane & 15) * (13.287712379549449f / 16.f));
    for (int r0 = gw; r0 < T; r0 += 2 * NGW) {
        unsigned w[2][4]; const int r1 = r0 + NGW;
#pragma unroll
        for (int j = 0; j < 4; ++j) { w[0][j] = *(const unsigned*)(QQ + (size_t)r0 * LDQQ + 2048 + j * 128 + 2 * lane); if (r1 < T) w[1][j] = *(const unsigned*)(QQ + (size_t)r1 * LDQQ + 2048 + j * 128 + 2 * lane); }
#pragma unroll
        for (int k = 0; k < 2; ++k) { const int r = k ? r1 : r0; if (r < T) {
            const int s = r & (SEQ - 1), ri = s >> 6, ci = s & 63;
            float cB, sB; rope_cs((float)((lane & 31) < 16 ? ri : ci) * fB, cB, sB);
#pragma unroll
            for (int j = 0; j < 4; ++j) { const float a = bflo(w[k][j]), b = bfhi(w[k][j]);
                *(unsigned*)(QQ + (size_t)r * LDQQ + 2048 + j * 128 + 2 * lane) = cvt_pk_bf16(a * cB - b * sB, a * sB + b * cB); } } }
    }
}
template <int J> __device__ __forceinline__ void pool_group(const bf16_t* XN, bf16_t* POOL, int r, int s, size_t base, int lane) {
    constexpr int hw = 1 << J, W = 2 * hw;
    const int lo = (s - hw) < 0 ? 0 : (s - hw), hi = (s + hw) > SEQ ? SEQ : (s + hw);
    u32x4 w[W];
#pragma unroll
    for (int i = 0; i < W; ++i) { int t = s - hw + i; t = t < 0 ? 0 : (t >= SEQ ? SEQ - 1 : t); w[i] = *(const u32x4*)(XN + (base + t) * DM + J * 512 + lane * 8); }
    float a[8] = {0.f, 0.f, 0.f, 0.f, 0.f, 0.f, 0.f, 0.f};
#pragma unroll
    for (int i = 0; i < W; ++i) { const int t = s - hw + i; const float f = (t >= 0 && t < SEQ) ? 1.f : 0.f;
        a[0] += f * bflo(w[i].x); a[1] += f * bfhi(w[i].x); a[2] += f * bflo(w[i].y); a[3] += f * bfhi(w[i].y); a[4] += f * bflo(w[i].z); a[5] += f * bfhi(w[i].z); a[6] += f * bflo(w[i].w); a[7] += f * bfhi(w[i].w); }
    const float inv = 1.0f / (float)(hi - lo);
    const u32x4 x = w[hw];
    u32x4 o; o.x = cvt_pk_bf16(a[0] * inv - bflo(x.x), a[1] * inv - bfhi(x.x)); o.y = cvt_pk_bf16(a[2] * inv - bflo(x.y), a[3] * inv - bfhi(x.y));
    o.z = cvt_pk_bf16(a[4] * inv - bflo(x.z), a[5] * inv - bfhi(x.z)); o.w = cvt_pk_bf16(a[6] * inv - bflo(x.w), a[7] * inv - bfhi(x.w));
    *(u32x4*)(POOL + (size_t)r * DM + J * 512 + lane * 8) = o;
}
__device__ __forceinline__ void pool_rows(const bf16_t* XN, bf16_t* POOL, int gw, int NGW, int lane) {
    for (int r = gw; r < T; r += NGW) {
        const int s = r & (SEQ - 1); const size_t base = (size_t)(r - s);
        pool_group<0>(XN, POOL, r, s, base, lane); pool_group<1>(XN, POOL, r, s, base, lane); pool_group<2>(XN, POOL, r, s, base, lane); pool_group<3>(XN, POOL, r, s, base, lane);
    }
}

#ifndef NDUP
#define NDUP 0
#define DUP_LIST {0}
#endif
__device__ __forceinline__ int slot_phase(int s) { constexpr int d[NDUP + 1] = DUP_LIST; int ph = s;
#pragma unroll
    for (int i = 0; i < NDUP; ++i) ph -= (s > d[i] + i) ? 1 : 0;
    return ph; }
enum { K_PRO = 0, K_GU, K_PLAIN, K_RESID, K_QKN, K_QROPE, K_ATT, K_POOL };
constexpr int NPHASE = 23;

__global__ void __launch_bounds__(512) mega_fwd(Params p) {
    extern __shared__ __attribute__((aligned(16))) unsigned char lds[];
    cg::grid_group grid = cg::this_grid();
    volatile LAS unsigned* xst = (volatile LAS unsigned*)((LAS unsigned char*)lds + LDS_BYTES - 64);
    if (threadIdx.x == 0) { xst[0] = 0u; xst[1] = 0u; (void)xb_add(&((unsigned*)p.ws)[XB_XCNT(xb_xcc_id())], 1u); }
    __syncthreads();
    for (int slot = (int)p.ph_lo; slot < (int)p.ph_hi; ++slot) {
        const int ph = slot_phase(slot);
        if (ph == 7) continue;
        int G = gridDim.x, bx = blockIdx.x; asm volatile("" : "+s"(G), "+s"(bx));
        const int NGW = G * 8;
        size_t zoff = 0; asm volatile("" : "+s"(zoff));
        unsigned char* ws = p.ws + zoff;
        bf16_t* XN = (bf16_t*)(ws + WS_XN); bf16_t* Hb = (bf16_t*)(ws + WS_H); bf16_t* QQ = (bf16_t*)(ws + WS_QQ); bf16_t* PB = (bf16_t*)(ws + WS_PB);
        bf16_t* MIX = (bf16_t*)(ws + WS_MIX); bf16_t* POOL = (bf16_t*)(ws + WS_POOL); bf16_t* KVb = XN;
        unsigned char* ob = (unsigned char*)p.out + zoff;
        unsigned char* mixw = ob + OUT_MIXW;
        bf16_t* Win_t = (bf16_t*)(mixw + OFF_WIN); bf16_t* Wuq_t = (bf16_t*)(mixw + OFF_WUQ); bf16_t* Wukv_t = (bf16_t*)(mixw + OFF_WUKV); bf16_t* Wout_t = (bf16_t*)(mixw + OFF_WOUT); bf16_t* Wpool_t = (bf16_t*)(mixw + OFF_WPOOL);
        bf16_t* X16 = (bf16_t*)(ws + WS_X16);
        int kind = K_PRO, fs = 0, ngemm = 1;
        const int tid = opaque_tid(), lane = tid & 63, wave = __builtin_amdgcn_readfirstlane(tid >> 6), gw = bx * 8 + wave;
        if (ph == 0) kind = K_PRO;
        else if (ph == 1 || ph == 11 || ph == 14 || ph == 20) { kind = K_GU; fs = ph == 1 ? 0 : ph == 11 ? 1 : ph == 14 ? 2 : 3; }
        else if (ph == 2 || ph == 12 || ph == 15 || ph == 21) { kind = K_PLAIN; fs = ph == 2 ? 0 : ph == 12 ? 1 : ph == 15 ? 2 : 3; }
        else if (ph == 3 || ph == 13 || ph == 16 || ph == 22 || ph == 10 || ph == 19) kind = K_RESID;
        else if (ph == 4 || ph == 9 || ph == 18) kind = K_PLAIN;
        else if (ph == 6) { kind = K_PLAIN; ngemm = 2; }
        else if (ph == 5) kind = K_QKN;
        else if (ph == 7) kind = K_QROPE;
        else if (ph == 8) kind = K_ATT;
        else if (ph == 17) kind = K_POOL;

        if (kind == K_PRO) {
            for (int s = 0; s < 4; ++s) {
                const int b = s == 0 ? 2 : s == 1 ? 17 : s == 2 ? 22 : 31;
                unsigned char* wb = s < 3 ? ob + (size_t)s * FFN_W_BYTES : ws + WS_W3; bf16_t* Wgu = (bf16_t*)wb; bf16_t* Wd = (bf16_t*)(wb + WGU_BYTES);
                transpose_matrix(p.in[b + 1], DM, DFF, Wgu, DM, 1, gw, NGW, lane);
                transpose_matrix(p.in[b + 2], DM, DFF, Wgu, DM, 2, gw, NGW, lane);
                transpose_matrix(p.in[b + 3], DFF, DM, Wd, DFF, 0, gw, NGW, lane);
            }
            transpose_matrix(p.in[8], DM, 2368, Win_t, DM, 0, gw, NGW, lane);
            for (int i = gw * 64 + lane; i < (2560 - 2368) * DM / 8; i += NGW * 64) *(u32x4*)(Win_t + (size_t)2368 * DM + (size_t)i * 8) = (u32x4){0u, 0u, 0u, 0u};
            transpose_matrix(p.in[12], 512, 1536, Wuq_t, 512, 3, gw, NGW, lane, 0.10411755f);
            transpose_matrix(p.in[14], 256, 2048, Wukv_t, 256, 0, gw, NGW, lane);
            transpose_matrix(p.in[15], 2048, 2048, Wout_t, 2048, 0, gw, NGW, lane);
            for (int gi = 0; gi < 4; ++gi) transpose_matrix(p.in[28] + (size_t)gi * 512 * 512, 512, 512, Wpool_t + (size_t)gi * 512 * 512, 512, 0, gw, NGW, lane, 1.0f, p.in[29] + gi * 512);
            prenorm_rows(p, p.in[2], XN, gw, NGW, lane);
        } else if (kind == K_GU) {
            bf16_t* Wgu = (bf16_t*)(fs < 3 ? ob + (size_t)fs * FFN_W_BYTES : ws + WS_W3);
            pg8::Gemm g{XN, Wgu, DM, DM, T, 2 * DFF, DM, 0}; pg8::StaticOrder S; S.init(T, 2 * DFF, G, bx);
            pg8::EpiSwiGLU E{Hb, DFF};
            pg8::gemm_phase<pg8::EpiSwiGLU>((LAS unsigned char*)lds, g, S, E);
        } else if (kind == K_PLAIN) {
            for (int q = 0; q < ngemm; ++q) {
                pg8::Gemm g; pg8::EpiBf16 E{nullptr, 0, 0, 0, nullptr, 0};
                if (ph == 4) { g = pg8::Gemm{XN, Win_t, DM, DM, T, 2560, DM, 0}; E = pg8::EpiBf16{QQ, LDQQ, 0, 1, PB, LDPB}; }
                else if (ph == 6 && q == 0) { g = pg8::Gemm{PB, Wuq_t, LDPB, 512, T, 1536, 512, 0}; E = pg8::EpiBf16{QQ, LDQQ, 1024, 2, nullptr, 0}; }
                else if (ph == 6) { g = pg8::Gemm{PB + 512, Wukv_t, LDPB, 256, T, 2048, 256, 0}; E = pg8::EpiBf16{KVb, DM, 0, 0, nullptr, 0}; }
                else if (ph == 9) { g = pg8::Gemm{QQ, Wout_t, LDQQ, DM, T, DM, DM, 0}; E = pg8::EpiBf16{MIX, DM, 0, 0, nullptr, 0}; }
                else if (ph == 18) { g = pg8::Gemm{POOL, Wpool_t, DM, 512, T, DM, 512, 2}; E = pg8::EpiBf16{MIX, DM, 0, 0, nullptr, 0}; }
                else { bf16_t* Wd = (bf16_t*)((fs < 3 ? ob + (size_t)fs * FFN_W_BYTES : ws + WS_W3) + WGU_BYTES); g = pg8::Gemm{Hb, Wd, DFF, DFF, T, DM, DFF, 0}; E = pg8::EpiBf16{XN, DM, 0, 0, nullptr, 0}; }
                pg8::StaticOrder S; S.init(T, g.N, G, bx, (g.N == DM) ? 4 : 8);
                pg8::gemm_phase<pg8::EpiBf16>((LAS unsigned char*)lds, g, S, E);
            }
        } else if (kind == K_RESID) {
            const bf16_t* Y; const float* cs = nullptr; const float* post; const float* next; float alpha = 0.5f; bool first = false;
            if (ph == 3) { Y = XN; post = p.in[6]; next = p.in[7]; first = true; }
            else if (ph == 10) { Y = MIX; post = p.in[16]; next = p.in[17]; alpha = 1.f; }
            else if (ph == 13) { Y = XN; post = p.in[21]; next = p.in[22]; }
            else if (ph == 16) { Y = XN; post = p.in[26]; next = p.in[27]; }
            else if (ph == 19) { Y = MIX; post = p.in[30]; next = p.in[31]; alpha = 1.f; }
            else { Y = XN; post = p.in[35]; next = nullptr; }
            resid_rows(p, Y, cs, post, alpha, first, next, XN, X16, gw, NGW, lane);
        } else if (kind == K_QKN) {
            qknorm_rows(p, QQ, PB, gw, NGW, lane);
        } else if (kind == K_QROPE) {
            qrope_rows(QQ, gw, NGW, lane);
        } else if (kind == K_ATT) {
            for (int u = bx; u < 3072; u += G) {
                const int mla = u / 1536, v = u % 1536, grp = v >> 8, w = v & 255, bh = grp * 8 + (w & 7), qb = w >> 3, b = bh >> 3, h = bh & 7;
                const size_t row0 = (size_t)b * SEQ, q0 = row0 + (size_t)qb * 256;
                if (!mla) {
                    att::attn_unit<false>(QQ + q0 * LDQQ + h * 128, nullptr, QQ + row0 * LDQQ + 2560 + (h >> 2) * 128, nullptr, QQ + row0 * LDQQ + 2816 + (h >> 2) * 128,
                                          QQ + q0 * LDQQ + h * 128, (char*)lds, (LAS unsigned char*)lds);
                } else {
                    att::attn_unit<true>(QQ + q0 * LDQQ + 1024 + h * 128, QQ + q0 * LDQQ + 2048 + h * 64, KVb + row0 * DM + h * 256, PB + row0 * LDPB + 768, KVb + row0 * DM + h * 256 + 128,
                                         QQ + q0 * LDQQ + 1024 + h * 128, (char*)lds, (LAS unsigned char*)lds);
                }
            }
        } else if (kind == K_POOL) {
            pool_rows(XN, POOL, gw, NGW, lane);
        }
        if (slot + 1 < (int)p.ph_hi) { if (slot == 0) grid.sync(); else xcd_barrier((unsigned*)ws, xst); }
    }
}

extern "C" void kernel_launch(void* const* d_in, const int* in_sizes, int n_in, void* d_out, int out_size, void* d_ws, size_t ws_size, hipStream_t stream) {
    static int grid = 0;
    if (grid == 0) {
        if (n_in != 36 || ws_size < WS_END || out_size != T * DM) { fprintf(stderr, "kernel_launch: unexpected shapes n_in %d ws %zu out %d\n", n_in, ws_size, out_size); grid = -1; return; }
        int dev = 0, cus = 0, per_cu = 0;
        hipGetDevice(&dev); hipDeviceGetAttribute(&cus, hipDeviceAttributeMultiprocessorCount, dev);
        hipFuncSetAttribute((const void*)mega_fwd, hipFuncAttributeMaxDynamicSharedMemorySize, LDS_BYTES);
        hipOccupancyMaxActiveBlocksPerMultiprocessor(&per_cu, (const void*)mega_fwd, 512, LDS_BYTES);
        if (per_cu < 1) per_cu = 1;
        if (per_cu > 1) per_cu = 1;
        grid = cus * per_cu;
        fprintf(stderr, "kernel_launch: grid %d (cus %d) ws %zu\n", grid, cus, ws_size);
    }
    if (grid < 0) return;
    if (hipMemsetAsync(d_ws, 0, 16384, stream) != hipSuccess) { fprintf(stderr, "kernel_launch: memset failed\n"); return; }
    Params p{};
    for (int i = 0; i < 36; ++i) p.in[i] = (const float*)d_in[i];
    p.out = (float*)d_out; p.ws = (unsigned char*)d_ws; p.ph_lo = 0; p.ph_hi = NPHASE + NDUP;
    void* args[] = {&p};
    hipError_t e = hipLaunchCooperativeKernel((const void*)mega_fwd, dim3(grid), dim3(512), args, LDS_BYTES, stream);
    if (e != hipSuccess) fprintf(stderr, "cooperative launch failed: %s (grid %d)\n", hipGetErrorString(e), grid);
}
```
